# Optimizing an MI355X kernel written in HIP

```python
import jax, jax.numpy as jnp
from jax import lax
import numpy as np

D_MODEL = 1024
BATCH = 16
SEQ = 2048
DEPTH = 1
DEC_BATCH = 8
DEC_SEQ = 32
PAST_LEN = 4096

CHUNK = 64
D_HEAD = 64
H_A = 6
H_B = 6
H_M = 4
D_A = H_A * D_HEAD
D_B = H_B * D_HEAD
D_M = H_M * D_HEAD
D_MIX = D_A + D_B + D_M
A_LEFT_CHUNKS = 8
A_WINDOW = A_LEFT_CHUNKS * CHUNK
REL_CLIP = 256
H_IDX = 8
D_IDX = 32
TOPK_MAX = 256
N_MEM = 256
Q_BLOCK = 128
ROPE_THETA = 10000.0
EPS = 1e-6
ATTN_SCALE = D_HEAD ** -0.5
COL_SIZES = (D_A, D_A, D_A, D_A, D_B, D_B, D_B, D_B, D_M, D_M, H_IDX * D_IDX, D_IDX, H_IDX)
IN_COLS = sum(COL_SIZES)

kernel_name = 'hymba_chunk_band_dsa_memory_step'


def _rmsnorm(x, g):
    xf = x.astype(jnp.float32)
    y = xf * lax.rsqrt(jnp.mean(xf * xf, axis=-1, keepdims=True) + EPS)
    return (y * g.astype(jnp.float32)).astype(x.dtype)


def _rope(x, pos):
    d = x.shape[-1]
    half = d // 2
    inv_freq = ROPE_THETA ** (-jnp.arange(half, dtype=jnp.float32) * 2.0 / d)
    ang = pos.astype(jnp.float32)[:, None] * inv_freq[None, :]
    cos = jnp.cos(ang)[:, None, :]
    sin = jnp.sin(ang)[:, None, :]
    xf = x.astype(jnp.float32)
    x1, x2 = xf[..., :half], xf[..., half:]
    return jnp.concatenate([x1 * cos - x2 * sin, x2 * cos + x1 * sin], axis=-1).astype(x.dtype)


def _split_cols(z):
    offs = [int(o) for o in np.cumsum(COL_SIZES)[:-1]]
    return jnp.split(z, offs, axis=-1)


def _mixer_inputs(x, g, w_in, pos):
    B, T, _ = x.shape
    z = _rmsnorm(x, g) @ w_in
    qa, ka, va, ga, qb, kb, vb, gb, qm, gm, qi, ki, wi = _split_cols(z)
    hd = lambda t, n: t.reshape(B, T, n, D_HEAD)
    qa, ka, va = hd(qa, H_A), hd(ka, H_A), hd(va, H_A)
    qb, kb, vb = _rope(hd(qb, H_B), pos), _rope(hd(kb, H_B), pos), hd(vb, H_B)
    qm = hd(qm, H_M)
    qi = _rope(qi.reshape(B, T, H_IDX, D_IDX), pos)
    ki = _rope(ki.reshape(B, T, 1, D_IDX), pos)[:, :, 0]
    return qa, ka, va, ga, qb, kb, vb, gb, qm, gm, qi, ki, wi


def _memory_kv(mem, g, w_mem_kv):
    B, N, _ = mem.shape
    mk, mv = jnp.split(_rmsnorm(mem, g) @ w_mem_kv, 2, axis=-1)
    return mk.reshape(B, N, H_M, D_HEAD), mv.reshape(B, N, H_M, D_HEAD)


def _attend(q, k, v, bias):
    s = jnp.einsum('bqhd,bkhd->bhqk', q, k).astype(jnp.float32) * ATTN_SCALE
    if bias is not None:
        s = s + bias
    p = jax.nn.softmax(s, axis=-1).astype(v.dtype)
    return jnp.einsum('bhqk,bkhd->bqhd', p, v)


def _rel_bias(table, q_pos, k_pos):
    d = jnp.clip(q_pos[:, None] - k_pos[None, :], -REL_CLIP, REL_CLIP) + REL_CLIP
    return table[:, d].astype(jnp.float32)


def _band_prompt(q, k, v, table):
    B, S, H, dh = q.shape
    nc = S // CHUNK
    band = A_WINDOW + CHUNK
    pad = ((0, 0), (A_WINDOW, 0), (0, 0), (0, 0))
    k_pad, v_pad = jnp.pad(k, pad), jnp.pad(v, pad)
    bias = _rel_bias(table, A_WINDOW + jnp.arange(CHUNK), jnp.arange(band))[None]
    q_chunks = jnp.moveaxis(q.reshape(B, nc, CHUNK, H, dh), 1, 0)

    def one_chunk(args):
        q_c, c = args
        start = c * CHUNK
        k_c = lax.dynamic_slice_in_dim(k_pad, start, band, axis=1)
        v_c = lax.dynamic_slice_in_dim(v_pad, start, band, axis=1)
        valid = (start + jnp.arange(band)) >= A_WINDOW
        return _attend(q_c, k_c, v_c, jnp.where(valid[None, None, None, :], bias, -jnp.inf))

    o = lax.map(one_chunk, (q_chunks, jnp.arange(nc)))
    return jnp.moveaxis(o, 0, 1).reshape(B, S, H * dh)


def _band_sample(q, k_new, v_new, k_cache, v_cache, table):
    B, T, H, dh = q.shape
    P = k_cache.shape[1]
    k = jnp.concatenate([k_cache, k_new], axis=1)
    v = jnp.concatenate([v_cache, v_new], axis=1)
    bias = _rel_bias(table, P + jnp.arange(T), jnp.arange(P + T))[None]
    return _attend(q, k, v, bias).reshape(B, T, H * dh)


def _indexer_scores(qi, ki, wi):
    dots = jnp.einsum('bqhd,bsd->bqhs', qi, ki).astype(jnp.float32) * (D_IDX ** -0.5)
    w = wi.astype(jnp.float32) * (H_IDX ** -0.5)
    return jnp.einsum('bqh,bqhs->bqs', w, jax.nn.relu(dots))


def _gather_attend(q, k, v, scores, topk):
    top_val, top_idx = lax.top_k(scores, topk)
    gather = jax.vmap(lambda kb, ib: kb[ib])
    k_sel = gather(k, top_idx)
    v_sel = gather(v, top_idx)
    s = jnp.einsum('bqhd,bqkhd->bhqk', q, k_sel).astype(jnp.float32) * ATTN_SCALE
    s = jnp.where(jnp.isfinite(top_val)[:, None], s, -jnp.inf)
    p = jax.nn.softmax(s, axis=-1).astype(v.dtype)
    return jnp.einsum('bhqk,bqkhd->bqhd', p, v_sel)


def _dsa_prompt(q, k, v, qi, ki, wi):
    B, S, H, dh = q.shape
    topk = min(TOPK_MAX, S // 4)
    nb = S // Q_BLOCK
    k_pos = jnp.arange(S)
    to_blocks = lambda t: jnp.moveaxis(t.reshape((B, nb, Q_BLOCK) + t.shape[2:]), 1, 0)

    def one_block(args):
        q_b, qi_b, wi_b, start = args
        q_pos = start + jnp.arange(Q_BLOCK)
        admissible = k_pos[None, :] < (q_pos[:, None] // CHUNK + 1) * CHUNK
        sc = jnp.where(admissible[None], _indexer_scores(qi_b, ki, wi_b), -jnp.inf)
        return _gather_attend(q_b, k, v, sc, topk)

    o = lax.map(one_block, (to_blocks(q), to_blocks(qi), to_blocks(wi), jnp.arange(nb) * Q_BLOCK))
    return jnp.moveaxis(o, 0, 1).reshape(B, S, H * dh)


def _dsa_sample(q, k_new, v_new, qi, ki_new, wi, k_cache, v_cache, ki_cache):
    B, T, H, dh = q.shape
    k = jnp.concatenate([k_cache, k_new], axis=1)
    v = jnp.concatenate([v_cache, v_new], axis=1)
    ki = jnp.concatenate([ki_cache, ki_new], axis=1)
    topk = min(TOPK_MAX, k.shape[1] // 4)
    return _gather_attend(q, k, v, _indexer_scores(qi, ki, wi), topk).reshape(B, T, H * dh)


def _merge(x, oa, ob, om, ga, gb, gm, w_out):
    o = jnp.concatenate([oa * jax.nn.silu(ga), ob * jax.nn.silu(gb), om * jax.nn.silu(gm)], axis=-1)
    return x + o @ w_out


def setup_inputs(seed: int = 0) -> dict:
    key = jax.random.key(seed)
    ks = jax.random.split(key, 18)
    nrm = lambda k, shape, scale=1.0: jax.random.normal(k, shape, jnp.float32) * scale
    a_rows = min(A_WINDOW, PAST_LEN)
    return {
        'x_prompt': nrm(ks[0], (BATCH, SEQ, D_MODEL)),
        'x_sample': nrm(ks[1], (DEC_BATCH, DEC_SEQ, D_MODEL)),
        'mem_prompt': nrm(ks[2], (BATCH, N_MEM, D_MODEL)),
        'cache_a_k': nrm(ks[3], (DEPTH, DEC_BATCH, a_rows, H_A, D_HEAD)),
        'cache_a_v': nrm(ks[4], (DEPTH, DEC_BATCH, a_rows, H_A, D_HEAD)),
        'cache_b_k': nrm(ks[5], (DEPTH, DEC_BATCH, PAST_LEN, H_B, D_HEAD)),
        'cache_b_v': nrm(ks[6], (DEPTH, DEC_BATCH, PAST_LEN, H_B, D_HEAD)),
        'cache_b_kidx': nrm(ks[7], (DEPTH, DEC_BATCH, PAST_LEN, D_IDX)),
        'cache_mem_k': nrm(ks[8], (DEPTH, DEC_BATCH, N_MEM, H_M, D_HEAD)),
        'cache_mem_v': nrm(ks[9], (DEPTH, DEC_BATCH, N_MEM, H_M, D_HEAD)),
        'norm_mix_g': 1.0 + nrm(ks[10], (DEPTH, D_MODEL), 0.02),
        'w_in': nrm(ks[11], (DEPTH, D_MODEL, IN_COLS), D_MODEL ** -0.5),
        'rel_bias_a': nrm(ks[12], (DEPTH, H_A, 2 * REL_CLIP + 1), 0.1),
        'norm_mem_g': 1.0 + nrm(ks[13], (DEPTH, D_MODEL), 0.02),
        'w_mem_kv': nrm(ks[14], (DEPTH, D_MODEL, 2 * D_M), D_MODEL ** -0.5),
        'w_out': nrm(ks[15], (DEPTH, D_MIX, D_MODEL), D_MIX ** -0.5),
        'norm_final_g': 1.0 + nrm(ks[16], (D_MODEL,), 0.02),
    }


def reference(x_prompt, x_sample, mem_prompt, cache_a_k, cache_a_v, cache_b_k, cache_b_v, cache_b_kidx,
              cache_mem_k, cache_mem_v, norm_mix_g, w_in, rel_bias_a, norm_mem_g, w_mem_kv, w_out, norm_final_g):
    S = x_prompt.shape[1]
    T = x_sample.shape[1]
    P = cache_b_k.shape[2]
    pos_p = jnp.arange(S)
    pos_s = P + jnp.arange(T)
    keep = min(A_WINDOW, S)
    xp, xs = x_prompt, x_sample
    akp, avp, bkp, bvp, bip, mkp, mvp = [], [], [], [], [], [], []
    aks, avs, bks, bvs, bis = [], [], [], [], []
    for l in range(DEPTH):
        qa, ka, va, ga, qb, kb, vb, gb, qm, gm, qi, ki, wi = _mixer_inputs(xp, norm_mix_g[l], w_in[l], pos_p)
        mk, mv = _memory_kv(mem_prompt, norm_mem_g[l], w_mem_kv[l])
        oa = _band_prompt(qa, ka, va, rel_bias_a[l])
        ob = _dsa_prompt(qb, kb, vb, qi, ki, wi)
        om = _attend(qm, mk, mv, None).reshape(xp.shape[0], S, D_M)
        xp = _merge(xp, oa, ob, om, ga, gb, gm, w_out[l])
        akp.append(ka[:, S - keep:])
        avp.append(va[:, S - keep:])
        bkp.append(kb)
        bvp.append(vb)
        bip.append(ki)
        mkp.append(mk)
        mvp.append(mv)
        qa, ka, va, ga, qb, kb, vb, gb, qm, gm, qi, ki, wi = _mixer_inputs(xs, norm_mix_g[l], w_in[l], pos_s)
        oa = _band_sample(qa, ka, va, cache_a_k[l], cache_a_v[l], rel_bias_a[l])
        ob = _dsa_sample(qb, kb, vb, qi, ki, wi, cache_b_k[l], cache_b_v[l], cache_b_kidx[l])
        om = _attend(qm, cache_mem_k[l], cache_mem_v[l], None).reshape(xs.shape[0], T, D_M)
        xs = _merge(xs, oa, ob, om, ga, gb, gm, w_out[l])
        aks.append(ka)
        avs.append(va)
        bks.append(kb)
        bvs.append(vb)
        bis.append(ki)
    y_prompt = _rmsnorm(xp, norm_final_g)
    y_sample = _rmsnorm(xs, norm_final_g)
    st = lambda t: jnp.stack(t, axis=0)
    return (y_prompt, y_sample, st(akp), st(avp), st(bkp), st(bvp), st(bip), st(mkp), st(mvp),
            st(aks), st(avs), st(bks), st(bvs), st(bis))
```

```cpp
#include <hip/hip_runtime.h>
#include <hip/hip_cooperative_groups.h>
#include <cstdio>
#include <cstdint>
#include <cmath>
namespace cg = cooperative_groups;

#define DI __device__ __forceinline__
typedef unsigned short bf16_t;
typedef short bf16x8 __attribute__((ext_vector_type(8)));
typedef short s16x4 __attribute__((ext_vector_type(4)));
typedef float f32x4 __attribute__((ext_vector_type(4)));
typedef float f32x16 __attribute__((ext_vector_type(16)));
typedef unsigned u32x4 __attribute__((ext_vector_type(4)));
typedef unsigned u32x2 __attribute__((ext_vector_type(2)));

#ifndef REP0
#define REP0 1
#endif
#ifndef REP4
#define REP4 1
#endif
#ifndef REP1
#define REP1 1
#endif
#ifndef REP2
#define REP2 1
#endif
#ifndef REP3
#define REP3 1
#endif
constexpr int TP = 32768, TS = 256, TM = 4096;
constexpr int NCOL = 3880, NPAD = 4096;
constexpr float LOG2E = 1.4426950408889634f;
constexpr float QSCALE = 0.125f * LOG2E;

constexpr long O_YP = 0;
constexpr long O_YS = O_YP + 33554432L;
constexpr long O_AKP = O_YS + 262144;
constexpr long O_AVP = O_AKP + 3145728;
constexpr long O_BKP = O_AVP + 3145728;
constexpr long O_BVP = O_BKP + 12582912;
constexpr long O_BIP = O_BVP + 12582912;
constexpr long O_MKP = O_BIP + 1048576;
constexpr long O_MVP = O_MKP + 1048576;
constexpr long O_AKS = O_MVP + 1048576;
constexpr long O_AVS = O_AKS + 98304;
constexpr long O_BKS = O_AVS + 98304;
constexpr long O_BVS = O_BKS + 98304;
constexpr long O_BIS = O_BVS + 98304;

constexpr int SC_LD = 4160;
constexpr int MASK_LD_P = 64, MASK_LD_S = 132;
constexpr int SMEM_BYTES = 8 * SC_LD * 4;
constexpr int LDT = 80;
#define LAS __attribute__((address_space(3)))

struct Params {
  const float *x_p, *x_s, *mem_p, *cak, *cav, *cbk, *cbv, *cbi, *cmk, *cmv, *g_mix, *w_in, *relb, *g_mem, *w_mem, *w_out, *g_fin;
  float* out;
  bf16_t *WinT, *WmemT, *WoutT, *xn_p, *xn_s, *memn;
  float2* rope;
  bf16_t *Qa_p, *Ka_p, *Va_p, *Qb_p, *Kb_p, *Vb_p, *Gate_p, *Qm_p, *Qi_p, *Ki_p;
  float* Wi_p;
  bf16_t *Mk_p, *Mv_p;
  bf16_t *Qa_s, *Ka_s, *Va_s, *Qb_s, *Kb_s, *Vb_s, *Gate_s, *Qm_s, *Qi_s, *Ki_s;
  float* Wi_s;
  bf16_t *Mk_s, *Mv_s;
  unsigned *Mask_p, *Mask_s;
  bf16_t *O_p, *O_s;
  float* xch;
  unsigned* xcnt;
  unsigned* bar;
  unsigned* ctr;
  long use_cg;
};

DI unsigned cvt_pk_bf16(float lo, float hi) { unsigned r; asm("v_cvt_pk_bf16_f32 %0, %1, %2" : "=v"(r) : "v"(lo), "v"(hi)); return r; }
DI bf16_t f2bf(float x) { return (bf16_t)(cvt_pk_bf16(x, 0.f) & 0xffffu); }
DI float bf2f(unsigned v) { return __uint_as_float(v << 16); }
DI float wave_sum(float v) {
#pragma unroll
  for (int o = 32; o >= 1; o >>= 1) v += __shfl_xor(v, o);
  return v;
}
DI float silu(float v) { return v * __builtin_amdgcn_rcpf(1.0f + __expf(-v)); }

struct RowPtr { const float* src; const float* g; bf16_t* dst; };
template <int NR>
DI void p0_rownorm(const RowPtr (&rp)[NR], int lane) {
  float4 v[NR][4];
#pragma unroll
  for (int r = 0; r < NR; ++r)
#pragma unroll
    for (int j = 0; j < 4; ++j) v[r][j] = *(const float4*)(rp[r].src + j * 256 + lane * 4);
#pragma unroll
  for (int r = 0; r < NR; ++r) {
    float ss = 0.f;
#pragma unroll
    for (int j = 0; j < 4; ++j) ss += v[r][j].x * v[r][j].x + v[r][j].y * v[r][j].y + v[r][j].z * v[r][j].z + v[r][j].w * v[r][j].w;
    ss = wave_sum(ss);
    const float rs = rsqrtf(ss * (1.0f / 1024.0f) + 1e-6f);
#pragma unroll
    for (int j = 0; j < 4; ++j) {
      const float4 gg = *(const float4*)(rp[r].g + j * 256 + lane * 4);
      u32x2 o;
      o.x = cvt_pk_bf16(v[r][j].x * rs * gg.x, v[r][j].y * rs * gg.y);
      o.y = cvt_pk_bf16(v[r][j].z * rs * gg.z, v[r][j].w * rs * gg.w);
      *(u32x2*)(rp[r].dst + j * 256 + lane * 4) = o;
    }
  }
}

DI void p0_convert(const float* __restrict__ src, bf16_t* __restrict__ dst, int nb, long chunk, long dstride, long gtid, long gn) {
  const long c4 = chunk >> 2;
  for (int b = 0; b < nb; ++b) {
    const float* sp = src + b * chunk;
    bf16_t* dp = dst + b * dstride;
    long i = gtid;
    for (; i + 7 * gn < c4; i += 8 * gn) {
      float4 v[8];
#pragma unroll
      for (int k = 0; k < 8; ++k) v[k] = *(const float4*)(sp + (i + k * gn) * 4);
#pragma unroll
      for (int k = 0; k < 8; ++k) {
        u32x2 o;
        o.x = cvt_pk_bf16(v[k].x, v[k].y);
        o.y = cvt_pk_bf16(v[k].z, v[k].w);
        *(u32x2*)(dp + (i + k * gn) * 4) = o;
      }
    }
    for (; i < c4; i += gn) {
      const float4 v = *(const float4*)(sp + i * 4);
      u32x2 o;
      o.x = cvt_pk_bf16(v.x, v.y);
      o.y = cvt_pk_bf16(v.z, v.w);
      *(u32x2*)(dp + i * 4) = o;
    }
  }
}

DI void p0_transpose_w(const float* __restrict__ src, int N, int Kdim, bf16_t* __restrict__ dst, int tk, int tn, float* sm, bool valid, int t) {
  const int k0 = tk * 64, n0 = tn * 64;
  if (valid) {
#pragma unroll
    for (int i = 0; i < 16; ++i) {
      const int k = (t >> 6) + 4 * i, n = n0 + (t & 63);
      sm[k * 65 + (t & 63)] = (n < N) ? src[(long)(k0 + k) * N + n] : 0.f;
    }
  }
  __syncthreads();
  if (valid) {
#pragma unroll
    for (int i = 0; i < 8; ++i) {
      const int n = (t >> 5) + 8 * i, k = (t & 31) * 2;
      const unsigned u = cvt_pk_bf16(sm[k * 65 + n], sm[(k + 1) * 65 + n]);
      const int nperm = (n & 3) * 16 + (n >> 2);
      *(unsigned*)(dst + (long)(n0 + nperm) * Kdim + k0 + k) = u;
    }
  }
  __syncthreads();
}

template <int KS> DI int lds_byte(int r, int c) {
  const int st = (r >> 4) * KS + (c >> 5), ob = (r & 15) * 64 + (c & 31) * 2;
  return st * 1024 + (ob ^ (((ob >> 9) & 1) << 5));
}
template <int KS> DI void stage_rc(int b, int& R, int& C) {
  const int st = b >> 10, sb = b & 1023, swz = sb ^ (((sb >> 9) & 1) << 5);
  R = (st / KS) * 16 + swz / 64;
  C = (st % KS) * 32 + (swz % 64) / 2;
}
#define WAIT_V(n) asm volatile("s_waitcnt vmcnt(%0)" ::"n"(n) : "memory")
#define SCHED() __builtin_amdgcn_sched_barrier(0)

DI void gemm256(const bf16_t* __restrict__ A, const bf16_t* __restrict__ Bt, int K, int brow, int bcol, char* sb0, char* sb1, f32x4 (&acc)[8][4]) {
  constexpr int BK = 64, KS = 2, TILE_B = 256 * BK * 2, GL = TILE_B / 8192;
  int tid = threadIdx.x;
  asm volatile("" : "+v"(tid));
  const int wid = tid >> 6, lane = tid & 63, wr = wid >> 2, wc = wid & 3, fr = lane & 15, fq = lane >> 4;
  const bf16_t* Ab = A + (long)brow * K;
  const bf16_t* Bb = Bt + (long)bcol * K;
#define GLDS_STAGE(sb, kt) do { const char* ag_ = (const char*)Ab + (kt) * (BK * 2); const char* bg_ = (const char*)Bb + (kt) * (BK * 2);  \
    int t2_ = tid; asm volatile("" : "+v"(t2_));                                                                                          \
    _Pragma("unroll") for (int i = 0; i < GL; ++i) { int R_, C_; stage_rc<KS>((t2_ >> 6) * 1024 + i * 8192 + (t2_ & 63) * 16, R_, C_);     \
    const unsigned so_ = (unsigned)(R_ * K + C_) * 2u;                                                                                   \
    __builtin_amdgcn_global_load_lds((const unsigned*)(ag_ + so_), (LAS unsigned*)((LAS char*)(sb) + wid * 1024 + i * 8192), 16, 0, 0);          \
    __builtin_amdgcn_global_load_lds((const unsigned*)(bg_ + so_), (LAS unsigned*)((LAS char*)(sb) + TILE_B + wid * 1024 + i * 8192), 16, 0, 0); } } while (0)
#pragma unroll
  for (int m = 0; m < 8; ++m)
#pragma unroll
    for (int n = 0; n < 4; ++n) acc[m][n] = (f32x4){0.f, 0.f, 0.f, 0.f};
#define KSTEP(sb, ks) do { bf16x8 At[4], Bf[4];                                                                      \
    _Pragma("unroll") for (int n = 0; n < 4; ++n) Bf[n] = *(const bf16x8*)((sb) + TILE_B + lds_byte<KS>(wc * 64 + n * 16 + fr, (ks) * 32 + fq * 8)); \
    _Pragma("unroll") for (int mh = 0; mh < 2; ++mh) {                                                                  \
      _Pragma("unroll") for (int m = 0; m < 4; ++m) At[m] = *(const bf16x8*)((sb) + lds_byte<KS>(wr * 128 + (mh * 4 + m) * 16 + fr, (ks) * 32 + fq * 8)); \
      _Pragma("unroll") for (int m = 0; m < 4; ++m) _Pragma("unroll") for (int n = 0; n < 4; ++n)                        \
        acc[mh * 4 + m][n] = __builtin_amdgcn_mfma_f32_16x16x32_bf16(At[m], Bf[n], acc[mh * 4 + m][n], 0, 0, 0);       \
    } SCHED(); } while (0)
#define COMPUTE(sb) do { _Pragma("unroll") for (int ks = 0; ks < KS; ++ks) KSTEP(sb, ks); } while (0)
  const int nt = K / BK;
  __syncthreads();
  GLDS_STAGE(sb0, 0); WAIT_V(0); __syncthreads();
  for (int t = 0; t < nt; t += 2) {
    GLDS_STAGE(sb1, t + 1);
    COMPUTE(sb0);
    WAIT_V(0); __syncthreads();
    if (t + 2 < nt) GLDS_STAGE(sb0, t + 2);
    COMPUTE(sb1);
    WAIT_V(0); __syncthreads();
  }
}

#define ROWLOOP8 _Pragma("unroll") for (int m = 0; m < 8; ++m) _Pragma("unroll") for (int j = 0; j < 4; ++j)
DI void st_bf4(bf16_t* p, float a, float b, float c, float d) { u32x2 o; o.x = cvt_pk_bf16(a, b); o.y = cvt_pk_bf16(c, d); *(u32x2*)p = o; }
DI void st_f4(float* p, float a, float b, float c, float d) { *(float4*)p = make_float4(a, b, c, d); }

template <bool SAMPLE>
DI void epi_mix8(const Params& p, f32x4 (&acc)[8][4], int R0, int cgc, int lane) {
  if (cgc >= 3904) return;
  asm volatile("" : "+v"(lane));
  const int fr = lane & 15, fq = lane >> 4;
  int seg, segoff;
  if (cgc < 3072) { seg = cgc / 384; segoff = cgc - seg * 384; }
  else if (cgc < 3328) { seg = 8; segoff = cgc - 3072; }
  else if (cgc < 3584) { seg = 9; segoff = cgc - 3328; }
  else if (cgc < 3840) { seg = 10; segoff = cgc - 3584; }
  else { seg = 11; segoff = 0; }
  const int c0 = segoff + 4 * fr;
  float* out = p.out;
#define ROWINFO                                                                                   \
  SCHED();                                                                                        \
  const int R = R0 + m * 16 + fq * 4 + j;                                                         \
  const int bb = SAMPLE ? (R >> 5) : (R >> 11);                                                   \
  const int tt = SAMPLE ? (R & 31) : (R & 2047);                                                  \
  const long rowA = SAMPLE ? (long)(bb * 544 + 512 + tt) : (long)R;                               \
  const long rowB = SAMPLE ? (long)(bb * 4128 + 4096 + tt) : (long)R;                             \
  const int rrow = SAMPLE ? (2048 + tt) : tt;                                                     \
  const float v0 = acc[m][0][j], v1 = acc[m][1][j], v2 = acc[m][2][j], v3 = acc[m][3][j];        \
  (void)bb; (void)tt; (void)rowA; (void)rowB; (void)rrow;
#define ROPE64                                                                                    \
  if ((j & 1) == 0) {                                                                             \
    _Pragma("unroll") for (int jj = 0; jj < 2; ++jj) {                                            \
      csA[jj] = *(const float4*)(p.rope + (rrow + jj) * 32 + 4 * (fr & 7));                       \
      csB[jj] = *(const float4*)(p.rope + (rrow + jj) * 32 + 4 * (fr & 7) + 2); } }               \
  const float4 csa = csA[j & 1], csb = csB[j & 1];                                                       \
  const float x0 = __shfl_xor(v0, 8), x1 = __shfl_xor(v1, 8), x2 = __shfl_xor(v2, 8), x3 = __shfl_xor(v3, 8); \
  const float sg = (fr < 8) ? -1.f : 1.f;                                                         \
  const float y0 = v0 * csa.x + sg * x0 * csa.y, y1 = v1 * csa.z + sg * x1 * csa.w;               \
  const float y2 = v2 * csb.x + sg * x2 * csb.y, y3 = v3 * csb.z + sg * x3 * csb.w;
#define ROPE32                                                                                    \
  if ((j & 1) == 0) {                                                                             \
    _Pragma("unroll") for (int jj = 0; jj < 2; ++jj)                                              \
      _Pragma("unroll") for (int q = 0; q < 4; ++q) c32[jj][q] = p.rope[(rrow + jj) * 32 + 8 * (fr & 3) + 2 * q]; } \
  const float2 ca = c32[j & 1][0], cb = c32[j & 1][1], cc = c32[j & 1][2], cd = c32[j & 1][3];                   \
  const float x0 = __shfl_xor(v0, 4), x1 = __shfl_xor(v1, 4), x2 = __shfl_xor(v2, 4), x3 = __shfl_xor(v3, 4); \
  const float sg = (fr & 4) ? 1.f : -1.f;                                                         \
  const float y0 = v0 * ca.x + sg * x0 * ca.y, y1 = v1 * cb.x + sg * x1 * cb.y;                   \
  const float y2 = v2 * cc.x + sg * x2 * cc.y, y3 = v3 * cd.x + sg * x3 * cd.y;
  switch (seg) {
    case 0: {
      bf16_t* dst = SAMPLE ? p.Qa_s : p.Qa_p;
      ROWLOOP8 { ROWINFO st_bf4(dst + (long)R * 384 + c0, v0 * QSCALE, v1 * QSCALE, v2 * QSCALE, v3 * QSCALE); }
    } break;
    case 8: {
      bf16_t* dst = SAMPLE ? p.Qm_s : p.Qm_p;
      ROWLOOP8 { ROWINFO st_bf4(dst + (long)R * 256 + c0, v0 * QSCALE, v1 * QSCALE, v2 * QSCALE, v3 * QSCALE); }
    } break;
    case 4: {
      bf16_t* dst = SAMPLE ? p.Qb_s : p.Qb_p;
      float4 csA[2], csB[2];
      ROWLOOP8 { ROWINFO ROPE64 st_bf4(dst + (long)R * 384 + c0, y0 * QSCALE, y1 * QSCALE, y2 * QSCALE, y3 * QSCALE); }
    } break;
    case 1: case 2: {
      bf16_t* dst = (seg == 1) ? (SAMPLE ? p.Ka_s : p.Ka_p) : (SAMPLE ? p.Va_s : p.Va_p);
      float* o = out + (SAMPLE ? (seg == 1 ? O_AKS : O_AVS) : (seg == 1 ? O_AKP : O_AVP));
      ROWLOOP8 { ROWINFO
        st_bf4(dst + rowA * 384 + c0, v0, v1, v2, v3);
        if (SAMPLE) st_f4(o + (long)R * 384 + c0, v0, v1, v2, v3);
        else if (tt >= 1536) st_f4(o + ((long)bb * 512 + (tt - 1536)) * 384 + c0, v0, v1, v2, v3);
      }
    } break;
    case 5: {
      bf16_t* dst = SAMPLE ? p.Kb_s : p.Kb_p;
      float* o = out + (SAMPLE ? O_BKS : O_BKP);
      float4 csA[2], csB[2];
      ROWLOOP8 { ROWINFO ROPE64
        st_bf4(dst + rowB * 384 + c0, y0, y1, y2, y3);
        st_f4(o + (long)R * 384 + c0, y0, y1, y2, y3);
      }
    } break;
    case 6: {
      bf16_t* dst = SAMPLE ? p.Vb_s : p.Vb_p;
      float* o = out + (SAMPLE ? O_BVS : O_BVP);
      ROWLOOP8 { ROWINFO
        st_bf4(dst + rowB * 384 + c0, v0, v1, v2, v3);
        st_f4(o + (long)R * 384 + c0, v0, v1, v2, v3);
      }
    } break;
    case 3: case 7: case 9: {
      bf16_t* dst = (SAMPLE ? p.Gate_s : p.Gate_p) + (seg == 3 ? 0 : (seg == 7 ? 384 : 768));
      ROWLOOP8 { ROWINFO st_bf4(dst + (long)R * 1024 + c0, silu(v0), silu(v1), silu(v2), silu(v3)); }
    } break;
    case 10: {
      bf16_t* dst = SAMPLE ? p.Qi_s : p.Qi_p;
      float2 c32[2][4];
      ROWLOOP8 { ROWINFO ROPE32 st_bf4(dst + (long)R * 256 + c0, y0, y1, y2, y3); }
    } break;
    default: {
      bf16_t* dst = SAMPLE ? p.Ki_s : p.Ki_p;
      float* o = out + (SAMPLE ? O_BIS : O_BIP);
      float* wdst = SAMPLE ? p.Wi_s : p.Wi_p;
      float2 c32[2][4];
      ROWLOOP8 { ROWINFO ROPE32
        if (fr < 8) { st_bf4(dst + rowB * 32 + 4 * fr, y0, y1, y2, y3); st_f4(o + (long)R * 32 + 4 * fr, y0, y1, y2, y3); }
        else if (fr < 10) st_f4(wdst + (long)R * 8 + 4 * (fr - 8), v0 * 0.0625f, v1 * 0.0625f, v2 * 0.0625f, v3 * 0.0625f);
      }
    } break;
  }
#undef ROWINFO
#undef ROPE64
#undef ROPE32
}

DI void tr8(unsigned addr, s16x4& l0, s16x4& l1, s16x4& l2, s16x4& l3, s16x4& h0, s16x4& h1, s16x4& h2, s16x4& h3) {
  asm volatile(
      "ds_read_b64_tr_b16 %0, %8\n\t"
      "ds_read_b64_tr_b16 %1, %8 offset:32\n\t"
      "ds_read_b64_tr_b16 %2, %8 offset:64\n\t"
      "ds_read_b64_tr_b16 %3, %8 offset:96\n\t"
      "ds_read_b64_tr_b16 %4, %8 offset:2560\n\t"
      "ds_read_b64_tr_b16 %5, %8 offset:2592\n\t"
      "ds_read_b64_tr_b16 %6, %8 offset:2624\n\t"
      "ds_read_b64_tr_b16 %7, %8 offset:2656\n\t"
      "s_waitcnt lgkmcnt(0)"
      : "=&v"(l0), "=&v"(l1), "=&v"(l2), "=&v"(l3), "=&v"(h0), "=&v"(h1), "=&v"(h2), "=&v"(h3)
      : "v"(addr)
      : "memory");
}

template <int MODE, bool F32KV = false>
DI void attn8(const bf16_t* __restrict__ Q, int ldq, int nq, const bf16_t* __restrict__ Kg, const bf16_t* __restrict__ Vg,
              int ldk, int nkeys, int tlo0, int thi0, int tlo1, int thi1, const bf16_t* __restrict__ gate, bf16_t* __restrict__ O,
              const float* __restrict__ biasg, int rel00, int rel01, const unsigned* __restrict__ maskg, int mask_ld, char* smem,
              const float* __restrict__ Kf = nullptr, const float* __restrict__ Vf = nullptr, int nf32t = 0) {
  bf16_t* sK = (bf16_t*)smem;
  bf16_t* sV = sK + 64 * LDT;
  float* sb = (float*)(sV + 64 * LDT);
  int tid = threadIdx.x;
  asm volatile("" : "+v"(tid));
  const int lane = tid & 63, wave = tid >> 6, c = lane & 15, g = lane >> 4;
  const int hf = wave >> 2, w4 = wave & 3;
  const int qin = w4 * 16 + c;
  const int qrow = hf * 64 + qin;
  const int qrc = qrow < nq ? qrow : nq - 1;
  const bool wactive = (hf * 64 + w4 * 16) < nq;
  const int tlo = hf ? tlo1 : tlo0, thi = hf ? thi1 : thi0, rel0 = hf ? rel01 : rel00;
  const int tbeg = tlo0 < tlo1 ? tlo0 : tlo1, tend = thi0 > thi1 ? thi0 : thi1;
  bf16x8 qB[2];
  qB[0] = *(const bf16x8*)(Q + (long)qrc * ldq + g * 8);
  qB[1] = *(const bf16x8*)(Q + (long)qrc * ldq + 32 + g * 8);
  __syncthreads();
  if (MODE == 1) {
    for (int i = tid; i < 513; i += 512) sb[i] = biasg[i] * LOG2E;
  }
  f32x4 o[4];
#pragma unroll
  for (int dt = 0; dt < 4; ++dt) o[dt] = (f32x4){0.f, 0.f, 0.f, 0.f};
  float m_run = -INFINITY, l_part = 0.f;
  const int skey = tid >> 3, sc16 = tid & 7;
  u32x4 aK0, aK1, aV0, aV1, bK0, bK1, bV0, bV1;
  aK1 = aV1 = bK1 = bV1 = (u32x4){0u, 0u, 0u, 0u};
  auto load_tile = [&](const int tile, u32x4& rk0, u32x4& rk1, u32x4& rv0, u32x4& rv1) __attribute__((always_inline)) {
    int key = tile * 64 + skey;
    key = key < nkeys ? key : nkeys - 1;
    if (F32KV && tile < nf32t) {
      const float* kp = Kf + (long)key * ldk + sc16 * 8;
      const float* vp = Vf + (long)key * ldk + sc16 * 8;
      rk0 = *(const u32x4*)kp; rk1 = *(const u32x4*)(kp + 4);
      rv0 = *(const u32x4*)vp; rv1 = *(const u32x4*)(vp + 4);
    } else {
      rk0 = *(const u32x4*)(Kg + (long)key * ldk + sc16 * 8);
      rv0 = *(const u32x4*)(Vg + (long)key * ldk + sc16 * 8);
    }
  };
  auto pack8 = [&](const u32x4& a, const u32x4& b) __attribute__((always_inline)) {
    u32x4 o;
    o.x = cvt_pk_bf16(__uint_as_float(a.x), __uint_as_float(a.y));
    o.y = cvt_pk_bf16(__uint_as_float(a.z), __uint_as_float(a.w));
    o.z = cvt_pk_bf16(__uint_as_float(b.x), __uint_as_float(b.y));
    o.w = cvt_pk_bf16(__uint_as_float(b.z), __uint_as_float(b.w));
    return o;
  };
  load_tile(tbeg, aK0, aK1, aV0, aV1);
  load_tile(tbeg + 1, bK0, bK1, bV0, bV1);
  const unsigned vaddr0 = (unsigned)(size_t)sV + (unsigned)((4 * g + (c >> 2)) * (LDT * 2) + (c & 3) * 8);
  u32x2 mwn = (u32x2){0u, 0u}, mwn2 = (u32x2){0u, 0u};
  if (MODE == 2) mwn2 = *(const u32x2*)(maskg + (long)qrc * mask_ld + tbeg * 2);
  auto step = [&](const int tile, u32x4& rk0, u32x4& rk1, u32x4& rv0, u32x4& rv1) __attribute__((always_inline)) {
    __syncthreads();
    if (F32KV && tile < nf32t) {
      *(u32x4*)(sK + skey * LDT + sc16 * 8) = pack8(rk0, rk1);
      *(u32x4*)(sV + skey * LDT + sc16 * 8) = pack8(rv0, rv1);
    } else {
      *(u32x4*)(sK + skey * LDT + sc16 * 8) = rk0;
      *(u32x4*)(sV + skey * LDT + sc16 * 8) = rv0;
    }
    __syncthreads();
    if (tile + 2 < tend) load_tile(tile + 2, rk0, rk1, rv0, rv1);
    if (MODE == 2) { mwn = mwn2; if (tile + 1 < tend) mwn2 = *(const u32x2*)(maskg + (long)qrc * mask_ld + (tile + 1) * 2); }
    if (wactive && tile >= tlo && tile < thi) {
      f32x4 s[4];
#pragma unroll
      for (int t = 0; t < 4; ++t) {
        s[t] = (f32x4){0.f, 0.f, 0.f, 0.f};
#pragma unroll
        for (int kb = 0; kb < 2; ++kb) {
          const bf16x8 kf = *(const bf16x8*)(sK + (16 * t + c) * LDT + kb * 32 + g * 8);
          s[t] = __builtin_amdgcn_mfma_f32_16x16x32_bf16(kf, qB[kb], s[t], 0, 0, 0);
        }
      }
      const int kbase = tile * 64 + 4 * g;
      if (MODE == 1) {
        if (rel0 + w4 * 16 - (tile * 64 + 63) >= 256) {
          const float bc = sb[512];
#pragma unroll
          for (int t = 0; t < 4; ++t)
#pragma unroll
            for (int i = 0; i < 4; ++i) s[t][i] += bc;
        } else {
#pragma unroll
          for (int t = 0; t < 4; ++t)
#pragma unroll
            for (int i = 0; i < 4; ++i) {
              int d = rel0 + qin - (kbase + 16 * t + i);
              d = d < -256 ? -256 : (d > 256 ? 256 : d);
              s[t][i] += sb[d + 256];
            }
        }
      }
      if (MODE == 2) {
        const u32x2 mw = mwn;
#pragma unroll
        for (int t = 0; t < 4; ++t) {
          const unsigned w = (t >> 1) ? mw.y : mw.x;
#pragma unroll
          for (int i = 0; i < 4; ++i) {
            const int bit = (t & 1) * 16 + 4 * g + i;
            if (!((w >> bit) & 1u)) s[t][i] = -INFINITY;
          }
        }
      }
      if (tile * 64 + 64 > nkeys) {
#pragma unroll
        for (int t = 0; t < 4; ++t)
#pragma unroll
          for (int i = 0; i < 4; ++i)
            if (kbase + 16 * t + i >= nkeys) s[t][i] = -INFINITY;
      }
      float mx = -INFINITY;
#pragma unroll
      for (int t = 0; t < 4; ++t)
#pragma unroll
        for (int i = 0; i < 4; ++i) mx = fmaxf(mx, s[t][i]);
      mx = fmaxf(mx, __shfl_xor(mx, 16));
      mx = fmaxf(mx, __shfl_xor(mx, 32));
      const float m_new = fmaxf(m_run, mx);
      const float m_safe = (m_new == -INFINITY) ? 0.f : m_new;
      const float alpha = __builtin_amdgcn_exp2f(m_run - m_safe);
      m_run = m_new;
      float psum = 0.f;
#pragma unroll
      for (int t = 0; t < 4; ++t)
#pragma unroll
        for (int i = 0; i < 4; ++i) {
          s[t][i] = __builtin_amdgcn_exp2f(s[t][i] - m_safe);
          psum += s[t][i];
        }
      l_part = l_part * alpha + psum;
#pragma unroll
      for (int dt = 0; dt < 4; ++dt)
#pragma unroll
        for (int i = 0; i < 4; ++i) o[dt][i] *= alpha;
#pragma unroll
      for (int kb2 = 0; kb2 < 2; ++kb2) {
        u32x4 pk;
        pk.x = cvt_pk_bf16(s[2 * kb2][0], s[2 * kb2][1]);
        pk.y = cvt_pk_bf16(s[2 * kb2][2], s[2 * kb2][3]);
        pk.z = cvt_pk_bf16(s[2 * kb2 + 1][0], s[2 * kb2 + 1][1]);
        pk.w = cvt_pk_bf16(s[2 * kb2 + 1][2], s[2 * kb2 + 1][3]);
        const bf16x8 pB = __builtin_bit_cast(bf16x8, pk);
        s16x4 lo[4], hi[4];
        tr8(vaddr0 + kb2 * 32 * (LDT * 2), lo[0], lo[1], lo[2], lo[3], hi[0], hi[1], hi[2], hi[3]);
#pragma unroll
        for (int dt = 0; dt < 4; ++dt) {
          const bf16x8 vf = __builtin_shufflevector(lo[dt], hi[dt], 0, 1, 2, 3, 4, 5, 6, 7);
          o[dt] = __builtin_amdgcn_mfma_f32_16x16x32_bf16(vf, pB, o[dt], 0, 0, 0);
        }
      }
    }
  };
  for (int tile = tbeg; tile < tend; tile += 2) {
    step(tile, aK0, aK1, aV0, aV1);
    if (tile + 1 < tend) step(tile + 1, bK0, bK1, bV0, bV1);
  }
  float l = l_part;
  l += __shfl_xor(l, 16);
  l += __shfl_xor(l, 32);
  const float inv = 1.0f / l;
  if (qrow < nq) {
#pragma unroll
    for (int dt = 0; dt < 4; ++dt) {
      const int d0 = 16 * dt + 4 * g;
      const u32x2 gg = *(const u32x2*)(gate + (long)qrow * 1024 + d0);
      u32x2 ov;
      ov.x = cvt_pk_bf16(o[dt][0] * inv * bf2f(gg.x & 0xffffu), o[dt][1] * inv * bf2f(gg.x >> 16));
      ov.y = cvt_pk_bf16(o[dt][2] * inv * bf2f(gg.y & 0xffffu), o[dt][3] * inv * bf2f(gg.y >> 16));
      *(u32x2*)(O + (long)qrow * 1024 + d0) = ov;
    }
  }
}

template <int NJ>
DI void select_query(const unsigned* sc, int N, unsigned* __restrict__ maskrow, int lane) {
  unsigned u[NJ];
#pragma unroll
  for (int j = 0; j < NJ; ++j) {
    const int idx = 64 * j + lane;
    u[j] = idx < N ? sc[idx] : 0u;
  }
  unsigned T = (N > 256) ? 0u : 1u;
  if (N > 256) {
    for (int bit = 31; bit >= 0; --bit) {
      const unsigned cand = T | (1u << bit);
      int cnt = 0;
#pragma unroll
      for (int j = 0; j < NJ; ++j) cnt += __popcll(__ballot(u[j] >= cand));
      if (cnt >= 256) { T = cand; if (cnt == 256) break; }
    }
  }
  int cgt = 0;
#pragma unroll
  for (int j = 0; j < NJ; ++j) cgt += __popcll(__ballot(u[j] > T));
  const int need = 256 - cgt;
  int running = 0;
#pragma unroll
  for (int j = 0; j < NJ; ++j) {
    const unsigned long long eq = __ballot(u[j] == T);
    const int rank = running + (int)__builtin_amdgcn_mbcnt_hi((unsigned)(eq >> 32), __builtin_amdgcn_mbcnt_lo((unsigned)eq, 0u));
    const bool sel = (u[j] > T) || (u[j] == T && rank < need);
    const unsigned long long sm = __ballot(sel);
    running += __popcll(eq);
    if (lane == 0) {
      u32x2 w;
      w.x = (unsigned)sm;
      w.y = (unsigned)(sm >> 32);
      *(u32x2*)(maskrow + 2 * j) = w;
    }
  }
}
DI void select_item8(const bf16_t* __restrict__ Qi, const float* __restrict__ Wi, long q0, const bf16_t* __restrict__ Ki, int N,
                     unsigned* __restrict__ maskbase, int mask_ld, char* smemA, char* smemB) {
  int tid = threadIdx.x;
  asm volatile("" : "+v"(tid));
  const int lane = tid & 63, wave = tid >> 6, r = lane & 31, hh = lane >> 5;
  const int hf = wave >> 2, w4 = wave & 3;
  unsigned* sc = (unsigned*)(hf ? smemB : smemA);
  const long qb = q0 + hf * 4;
  const int qsel = 2 * ((r >> 2) & 1) + (r >> 4), head = 4 * ((r >> 3) & 1) + (r & 3);
  bf16x8 a[2];
  a[0] = *(const bf16x8*)(Qi + (qb + qsel) * 256 + head * 32 + hh * 8);
  a[1] = *(const bf16x8*)(Qi + (qb + qsel) * 256 + head * 32 + 16 + hh * 8);
  float w[2][8];
#pragma unroll
  for (int qq = 0; qq < 2; ++qq) {
    const float4 w0 = *(const float4*)(Wi + (qb + 2 * hh + qq) * 8);
    const float4 w1 = *(const float4*)(Wi + (qb + 2 * hh + qq) * 8 + 4);
    w[qq][0] = w0.x; w[qq][1] = w0.y; w[qq][2] = w0.z; w[qq][3] = w0.w;
    w[qq][4] = w1.x; w[qq][5] = w1.y; w[qq][6] = w1.z; w[qq][7] = w1.w;
  }
  __syncthreads();
  const int ntile = (N + 31) >> 5;
  for (int nt = w4; nt < ntile; nt += 4) {
    const int key = nt * 32 + r;
    const int keyc = key < N ? key : N - 1;
    const bf16x8 b0 = *(const bf16x8*)(Ki + (long)keyc * 32 + hh * 8);
    const bf16x8 b1 = *(const bf16x8*)(Ki + (long)keyc * 32 + 16 + hh * 8);
    f32x16 acc;
#pragma unroll
    for (int i = 0; i < 16; ++i) acc[i] = 0.f;
    acc = __builtin_amdgcn_mfma_f32_32x32x16_bf16(a[0], b0, acc, 0, 0, 0);
    acc = __builtin_amdgcn_mfma_f32_32x32x16_bf16(a[1], b1, acc, 0, 0, 0);
#pragma unroll
    for (int qq = 0; qq < 2; ++qq) {
      float s = 0.f;
#pragma unroll
      for (int h = 0; h < 8; ++h) s += w[qq][h] * fmaxf(acc[8 * qq + h], 0.f);
      unsigned ub = __float_as_uint(s);
      ub = (ub & 0x80000000u) ? ~ub : (ub | 0x80000000u);
      if (key < N) sc[(2 * hh + qq) * SC_LD + key] = ub;
    }
  }
  __syncthreads();
  const unsigned* row = sc + w4 * SC_LD;
  unsigned* mrow = maskbase + (long)wave * mask_ld;
  if (N <= 512) select_query<8>(row, N, mrow, lane);
  else if (N <= 1024) select_query<16>(row, N, mrow, lane);
  else if (N <= 1536) select_query<24>(row, N, mrow, lane);
  else if (N <= 2048) select_query<32>(row, N, mrow, lane);
  else select_query<65>(row, N, mrow, lane);
}


#define XB_TMO      128
#define XB_XCNT(j)  (256  + 64 * (j))
#define XB_XSUB(j)  (1280 + 64 * (j))
#define XB_XGEN(j)  (2304 + 64 * (j))
#define XB_TOP      3328
#define XB_TOPGEN   3392
#define XCD_BAR_WORDS 3456
#define XB_SPIN_CAP (1u << 22)
DI unsigned xb_ld(unsigned* p) { return __hip_atomic_load(p, __ATOMIC_RELAXED, __HIP_MEMORY_SCOPE_AGENT); }
DI unsigned xb_add(unsigned* p, unsigned v) { return __hip_atomic_fetch_add(p, v, __ATOMIC_RELAXED, __HIP_MEMORY_SCOPE_AGENT); }
DI unsigned xb_xcc_id() { return (unsigned)__builtin_amdgcn_s_getreg((3 << 11) | 20) & 0xFu; }
#define XB_SPIN(cond, bar) do { unsigned _sp = 0; while (cond) { __builtin_amdgcn_s_sleep(1); \
    if ((++_sp & 255u) == 0u) { if (xb_ld(&(bar)[XB_TMO])) break; if (_sp > XB_SPIN_CAP) { atomicAdd(&(bar)[XB_TMO], 1u); break; } } } } while (0)
struct XcdBarrier { unsigned* bar; unsigned x; volatile LAS unsigned* st; };
DI XcdBarrier xcd_barrier_post(unsigned* bar, volatile LAS unsigned* st) {
  XcdBarrier b; b.bar = bar; b.x = xb_xcc_id(); b.st = st;
  if (threadIdx.x == 0) (void)xb_add(&bar[XB_XCNT(b.x)], 1u);
  return b;
}
DI void xcd_barrier_complete(unsigned* bar, unsigned x, unsigned& nloc, unsigned& nx) {
  const unsigned G = gridDim.x * gridDim.y * gridDim.z;
  unsigned sum, cnt, mine, sp = 0u;
  for (;;) {
    sum = 0u; cnt = 0u; mine = 0u;
#pragma unroll
    for (unsigned j = 0; j < 16; ++j) { const unsigned c = xb_ld(&bar[XB_XCNT(j)]); sum += c; cnt += (c > 0u) ? 1u : 0u; mine = (j == x) ? c : mine; }
    if (sum == G) break;
    __builtin_amdgcn_s_sleep(1);
    if ((++sp & 255u) == 0u) { if (xb_ld(&bar[XB_TMO])) break; if (sp > XB_SPIN_CAP) { atomicAdd(&bar[XB_TMO], 1u); break; } }
  }
  nloc = mine > 0u ? mine : 1u; nx = cnt > 0u ? cnt : 1u;
}
DI void xcd_barrier(const XcdBarrier& b) {
  asm volatile("s_waitcnt vmcnt(0)" ::: "memory");
  __syncthreads();
  if (threadIdx.x == 0) {
    unsigned* bar = b.bar;
    __builtin_amdgcn_s_waitcnt(0);
    unsigned nloc = b.st[0], nx = b.st[1];
    if (nloc == 0u) { xcd_barrier_complete(bar, b.x, nloc, nx); b.st[0] = nloc; b.st[1] = nx; }
    const unsigned old = xb_add(&bar[XB_XSUB(b.x)], 1u);
    const unsigned gen = old / nloc;
    if (old + 1u == (gen + 1u) * nloc) {
      __builtin_amdgcn_fence(__ATOMIC_RELEASE, "agent");
      asm volatile("s_waitcnt vmcnt(0)" ::: "memory");
      const unsigned og = xb_add(&bar[XB_TOP], 1u);
      const unsigned tg = og / nx;
      if (og + 1u == (tg + 1u) * nx) xb_add(&bar[XB_TOPGEN], 1u);
      else XB_SPIN(xb_ld(&bar[XB_TOPGEN]) == tg, bar);
      __builtin_amdgcn_fence(__ATOMIC_ACQUIRE, "agent");
      xb_add(&bar[XB_XGEN(b.x)], 1u);
      asm volatile("s_waitcnt vmcnt(0)" ::: "memory");
    } else {
      XB_SPIN(xb_ld(&bar[XB_XGEN(b.x)]) == gen, bar);
      __builtin_amdgcn_fence(__ATOMIC_ACQUIRE, "agent");
      asm volatile("s_waitcnt vmcnt(0)" ::: "memory");
    }
  }
  __syncthreads();
}

__global__ void __launch_bounds__(512, 2) fwd_megakernel(Params p) {
  cg::grid_group grid = cg::this_grid();
  __shared__ __attribute__((aligned(1024))) char smemA[SMEM_BYTES / 2];
  __shared__ __attribute__((aligned(1024))) char smemB[SMEM_BYTES / 2];
  char* const smem = smemA;
  __shared__ uint4 xb_words;
  __shared__ int s_next;
  const int tid = threadIdx.x, lane = tid & 63, wave = tid >> 6;
  const int nblk = gridDim.x, bid = blockIdx.x;
  if (tid == 0) xb_words = make_uint4(0u, 0u, 0u, 0u);
  __syncthreads();
  const XcdBarrier xb = xcd_barrier_post(p.bar, (volatile LAS unsigned*)&xb_words);
  if (p.use_cg) grid.sync();

  for (int rep0 = 0; rep0 < REP0; ++rep0) {
    const int half = tid >> 8, t = tid & 255;
    float* smf = (float*)smem + half * (64 * 65);
    for (int base = bid * 2; base < 1024 + 128 + 256; base += nblk * 2) {
      const int it = base + half;
      const bool valid = it < 1408;
      if (it < 1024) p0_transpose_w(p.w_in, NCOL, 1024, p.WinT, it >> 6, it & 63, smf, valid, t);
      else if (it < 1152) { const int j = it - 1024; p0_transpose_w(p.w_mem, 512, 1024, p.WmemT, j >> 3, j & 7, smf, valid, t); }
      else { const int j = (valid ? it : 1407) - 1152; p0_transpose_w(p.w_out, 1024, 1024, p.WoutT, j >> 4, j & 15, smf, valid, t); }
    }
    {
      const int nrows = TP + TS + TM, stride = nblk * 8;
      auto rowptr = [&](int row) {
        RowPtr r;
        if (row < TP) { r.src = p.x_p + (long)row * 1024; r.g = p.g_mix; r.dst = p.xn_p + (long)row * 1024; }
        else if (row < TP + TS) { const int r2 = row - TP; r.src = p.x_s + (long)r2 * 1024; r.g = p.g_mix; r.dst = p.xn_s + (long)r2 * 1024; }
        else { const int r2 = row - TP - TS; r.src = p.mem_p + (long)r2 * 1024; r.g = p.g_mem; r.dst = p.memn + (long)r2 * 1024; }
        return r;
      };
      int row = bid * 8 + wave;
      for (; row + 3 * stride < nrows; row += 4 * stride) {
        const RowPtr rp[4] = {rowptr(row), rowptr(row + stride), rowptr(row + 2 * stride), rowptr(row + 3 * stride)};
        p0_rownorm<4>(rp, lane);
      }
      for (; row < nrows; row += stride) {
        const RowPtr rp[1] = {rowptr(row)};
        p0_rownorm<1>(rp, lane);
      }
    }
    const long gtid = (long)bid * 512 + tid, gn = (long)nblk * 512;
    p0_convert(p.cak, p.Ka_s, 8, 512L * 384, 544L * 384, gtid, gn);
    p0_convert(p.cav, p.Va_s, 8, 512L * 384, 544L * 384, gtid, gn);
    p0_convert(p.cbi, p.Ki_s, 8, 4096L * 32, 4128L * 32, gtid, gn);
    p0_convert(p.cmk, p.Mk_s, 1, 8L * 256 * 256, 0, gtid, gn);
    p0_convert(p.cmv, p.Mv_s, 1, 8L * 256 * 256, 0, gtid, gn);
    for (long i = gtid; i < 2080 * 32; i += gn) {
      const int pr = (int)(i >> 5), k = (int)(i & 31);
      const int pos = pr < 2048 ? pr : (4096 + pr - 2048);
      const float invf = (float)exp2((double)k * -0.41524101186092029);
      const float ang = (float)pos * invf;
      double rev = (double)ang * 0.15915494309189533577;
      rev = rev - rint(rev);
      const float fr = (float)rev;
      p.rope[i] = make_float2(__builtin_amdgcn_cosf(fr), __builtin_amdgcn_sinf(fr));
    }
  }
  xcd_barrier(xb);

  {
    for (int round9 = 0; round9 < 9 * REP1; ++round9)
      for (int vb = bid; vb < 256; vb += nblk) {
        const int round = round9 % 9;
        int kind, gm, gn;
        if (round < 8) {
          const int xcd = vb & 7, slot = vb >> 3;
          kind = 0; gm = (round * 4 + (xcd >> 1)) * 4 + (slot & 3); gn = ((xcd + round) & 1) * 8 + (((slot >> 2) + round) & 7);
        } else if (vb < 16) { kind = 1; gm = 0; gn = vb; }
        else if (vb < 48) { kind = 2; gm = (vb - 16) >> 1; gn = (vb - 16) & 1; }
        else continue;
        const bf16_t* Ap = kind == 0 ? p.xn_p : (kind == 1 ? p.xn_s : p.memn);
        const bf16_t* Bp = kind == 2 ? p.WmemT : p.WinT;
        f32x4 acc[8][4];
        gemm256(Ap, Bp, 1024, gm * 256, gn * 256, smemA, smemB, acc);
        int tq = threadIdx.x;
        asm volatile("" : "+v"(tq));
        const int lane = tq & 63, wr = tq >> 8, wc = (tq >> 6) & 3;
        const int R0 = gm * 256 + wr * 128, cgc = gn * 256 + wc * 64;
        if (kind == 0) epi_mix8<false>(p, acc, R0, cgc, lane);
        else if (kind == 1) epi_mix8<true>(p, acc, R0, cgc, lane);
        else {
          const bool isv = cgc >= 256;
          bf16_t* dst = isv ? p.Mv_p : p.Mk_p;
          float* o = p.out + (isv ? O_MVP : O_MKP);
          const int cc = (cgc & 255) + 4 * (lane & 15);
          ROWLOOP8 {
            SCHED();
            const int R = R0 + m * 16 + (lane >> 4) * 4 + j;
            st_bf4(dst + (long)R * 256 + cc, acc[m][0][j], acc[m][1][j], acc[m][2][j], acc[m][3][j]);
            st_f4(o + (long)R * 256 + cc, acc[m][0][j], acc[m][1][j], acc[m][2][j], acc[m][3][j]);
          }
        }
      }
  }
  xcd_barrier(xb);

#define QUEUE_BEGIN(ctrp, total)                                              \
  { unsigned* _ctr = (ctrp); const int _total = (total);                     \
    __syncthreads();                                                          \
    if (tid == 0) s_next = (int)atomicAdd(_ctr, 1u);                          \
    __syncthreads();                                                          \
    int it = s_next;                                                          \
    while (it < _total) {                                                     \
      int _nxt = 0;                                                           \
      if (tid == 0) _nxt = (int)atomicAdd(_ctr, 1u);
#define QUEUE_END                                                             \
      __syncthreads();                                                        \
      if (tid == 0) s_next = _nxt;                                            \
      __syncthreads();                                                        \
      it = s_next;                                                            \
    } }

  {
    const int e0 = 32, e1 = e0 + 48, e2 = e1 + 32, e3 = e2 + 4096, e4 = e3 + 1536, e5 = e4 + 1024;
    QUEUE_BEGIN(p.ctr, REP2 * e5)
      const int iq = it % e5;
      if (iq < e0) {
        const int b = iq >> 2, qg = iq & 3;
        const long q0 = (long)b * 32 + qg * 8;
        select_item8(p.Qi_s, p.Wi_s, q0, p.Ki_s + (long)b * 4128 * 32, 4128, p.Mask_s + q0 * MASK_LD_S, MASK_LD_S, smemA, smemB);
      } else if (iq < e1) {
        const int j = iq - e0, b = j / 6, h = j % 6;
        attn8<1>(p.Qa_s + (long)b * 32 * 384 + h * 64, 384, 32, p.Ka_s + (long)b * 544 * 384 + h * 64, p.Va_s + (long)b * 544 * 384 + h * 64,
                 384, 544, 0, 9, 0, 0, p.Gate_s + (long)b * 32 * 1024 + h * 64, p.O_s + (long)b * 32 * 1024 + h * 64, p.relb + h * 513, 512, 0,
                 nullptr, 0, smem);
      } else if (iq < e2) {
        const int j = iq - e1, b = j >> 2, h = j & 3;
        attn8<0>(p.Qm_s + (long)b * 32 * 256 + h * 64, 256, 32, p.Mk_s + (long)b * 65536 + h * 64, p.Mv_s + (long)b * 65536 + h * 64, 256, 256,
                 0, 4, 0, 0, p.Gate_s + (long)b * 32 * 1024 + 768 + h * 64, p.O_s + (long)b * 32 * 1024 + 768 + h * 64, nullptr, 0, 0, nullptr, 0,
                 smem);
      } else if (iq < e3) {
        const int j = iq - e2, c = 31 - (j >> 7), rem = j & 127, b = rem >> 3, qg = rem & 7;
        const long q0 = (long)b * 2048 + c * 64 + qg * 8;
        select_item8(p.Qi_p, p.Wi_p, q0, p.Ki_p + (long)b * 2048 * 32, (c + 1) * 64, p.Mask_p + q0 * MASK_LD_P, MASK_LD_P, smemA, smemB);
      } else if (iq < e4) {
        const int j = iq - e3, b = j / 96, cp = (j / 6) & 15, h = j % 6;
        const int c0 = 2 * cp, c1 = c0 + 1, kb0 = c0 > 8 ? c0 - 8 : 0, k0 = kb0 * 64;
        const long row0 = (long)b * 2048 + c0 * 64, krow = (long)b * 2048 + k0;
        attn8<1>(p.Qa_p + row0 * 384 + h * 64, 384, 128, p.Ka_p + krow * 384 + h * 64, p.Va_p + krow * 384 + h * 64, 384, (c1 + 1) * 64 - k0,
                 0, c0 - kb0 + 1, (c1 > 8 ? c1 - 8 : 0) - kb0, c1 - kb0 + 1, p.Gate_p + row0 * 1024 + h * 64, p.O_p + row0 * 1024 + h * 64,
                 p.relb + h * 513, c0 * 64 - k0, c1 * 64 - k0, nullptr, 0, smem);
      } else {
        const int j = iq - e4, b = j >> 6, cp = (j >> 2) & 15, h = j & 3;
        const long row0 = (long)b * 2048 + cp * 128;
        attn8<0>(p.Qm_p + row0 * 256 + h * 64, 256, 128, p.Mk_p + (long)b * 65536 + h * 64, p.Mv_p + (long)b * 65536 + h * 64, 256, 256, 0, 4, 0, 4,
                 p.Gate_p + row0 * 1024 + 768 + h * 64, p.O_p + row0 * 1024 + 768 + h * 64, nullptr, 0, 0, nullptr, 0, smem);
      }
    QUEUE_END
  }
  xcd_barrier(xb);

  {
    const int nB_s = 48, nB_p = 1536;
    QUEUE_BEGIN(p.ctr + 64, REP3 * (nB_s + nB_p))
      const int iq = it % (nB_s + nB_p);
      if (iq < nB_s) {
        const int b = iq / 6, h = iq % 6;
        attn8<2, true>(p.Qb_s + (long)b * 32 * 384 + h * 64, 384, 32, p.Kb_s + (long)b * 4128 * 384 + h * 64, p.Vb_s + (long)b * 4128 * 384 + h * 64,
                 384, 4128, 0, 65, 0, 0, p.Gate_s + (long)b * 32 * 1024 + 384 + h * 64, p.O_s + (long)b * 32 * 1024 + 384 + h * 64, nullptr, 0, 0,
                 p.Mask_s + (long)b * 32 * MASK_LD_S, MASK_LD_S, smem, p.cbk + (long)b * 4096 * 384 + h * 64, p.cbv + (long)b * 4096 * 384 + h * 64, 64);
      } else {
        const int j = iq - nB_s, cp = 15 - j / 96, rem = j % 96, b = rem / 6, h = rem % 6;
        const int c0 = 2 * cp, c1 = c0 + 1;
        const long row0 = (long)b * 2048 + c0 * 64;
        attn8<2>(p.Qb_p + row0 * 384 + h * 64, 384, 128, p.Kb_p + (long)b * 2048 * 384 + h * 64, p.Vb_p + (long)b * 2048 * 384 + h * 64, 384,
                 (c1 + 1) * 64, 0, c0 + 1, 0, c1 + 1, p.Gate_p + row0 * 1024 + 384 + h * 64, p.O_p + row0 * 1024 + 384 + h * 64, nullptr, 0, 0,
                 p.Mask_p + row0 * MASK_LD_P, MASK_LD_P, smem);
      }
    QUEUE_END
  }
  xcd_barrier(xb);

  {
    const int wr = wave >> 2, wc = wave & 3, fr = lane & 15, fq = lane >> 4;
    float* red = (float*)smem;
    float* red2 = (float*)smem;
    float* rsv = (float*)smemB;
    for (int round = 0; round < 2; ++round)
      for (int vb = bid; vb < 256; vb += nblk) {
        const int gm = round * 64 + (vb & 7) * 8 + ((vb >> 3) & 7), gn = vb >> 6;
        f32x4 acc[8][4];
        gemm256(p.O_p, p.WoutT, 1024, gm * 256, gn * 256, smemA, smemB, acc);
        int tq = threadIdx.x;
        asm volatile("" : "+v"(tq));
        const int ln = tq & 63, wv = tq >> 6, wr = wv >> 2, wc = wv & 3;
        const int fr2 = ln & 15, fq2 = ln >> 4;
        const int R0 = gm * 256 + wr * 128, C0 = gn * 256 + wc * 64 + 4 * fr2;
        float4 xq[2][4];
#pragma unroll
        for (int jj = 0; jj < 4; ++jj) xq[0][jj] = *(const float4*)(p.x_p + (long)(gm * 256 + wr * 128 + fq2 * 4 + jj) * 1024 + C0);
        ROWLOOP8 {
          SCHED();
          const int rl = wr * 128 + m * 16 + fq2 * 4 + j;
          if (j == 0 && m < 7) {
#pragma unroll
            for (int jj = 0; jj < 4; ++jj) xq[(m + 1) & 1][jj] = *(const float4*)(p.x_p + (long)(gm * 256 + wr * 128 + (m + 1) * 16 + fq2 * 4 + jj) * 1024 + C0);
          }
          const float4 xv = xq[m & 1][j];
          const float v0 = acc[m][0][j] + xv.x, v1 = acc[m][1][j] + xv.y, v2 = acc[m][2][j] + xv.z, v3 = acc[m][3][j] + xv.w;
          acc[m][0][j] = v0; acc[m][1][j] = v1; acc[m][2][j] = v2; acc[m][3][j] = v3;
          red2[rl * 65 + wc * 16 + fr2] = v0 * v0 + v1 * v1 + v2 * v2 + v3 * v3;
        }
        __syncthreads();
        if (tq < 256) {
          float mine = 0.f;
#pragma unroll 16
          for (int q = 0; q < 64; ++q) mine += red2[tq * 65 + q];
          __hip_atomic_store(p.xch + (long)(gm * 4 + gn) * 256 + tq, mine, __ATOMIC_RELAXED, __HIP_MEMORY_SCOPE_AGENT);
        }
        asm volatile("s_waitcnt vmcnt(0)" ::: "memory");
        __syncthreads();
        if (tq == 0) {
          (void)__hip_atomic_fetch_add(p.xcnt + gm, 1u, __ATOMIC_RELAXED, __HIP_MEMORY_SCOPE_AGENT);
          unsigned sp = 0;
          while (__hip_atomic_load(p.xcnt + gm, __ATOMIC_RELAXED, __HIP_MEMORY_SCOPE_AGENT) < 4u) {
            __builtin_amdgcn_s_sleep(1);
            if (++sp > (1u << 22)) break;
          }
        }
        __syncthreads();
        if (tq < 256) {
          float t = 0.f;
#pragma unroll
          for (int g4 = 0; g4 < 4; ++g4) t += __hip_atomic_load(p.xch + (long)(gm * 4 + g4) * 256 + tq, __ATOMIC_RELAXED, __HIP_MEMORY_SCOPE_AGENT);
          rsv[tq] = rsqrtf(t * (1.0f / 1024.0f) + 1e-6f);
        }
        __syncthreads();
        const float4 gf = *(const float4*)(p.g_fin + C0);
        int fq3 = fq2;
        asm volatile("" : "+v"(fq3));
        ROWLOOP8 {
          SCHED();
          const int rl = wr * 128 + m * 16 + fq3 * 4 + j;
          const float rs = rsv[rl];
          st_f4(p.out + O_YP + (long)(gm * 256 + rl) * 1024 + C0, acc[m][0][j] * rs * gf.x, acc[m][1][j] * rs * gf.y, acc[m][2][j] * rs * gf.z,
                acc[m][3][j] * rs * gf.w);
        }
      }
    __syncthreads();
    if (bid < 16) {
      int tss = threadIdx.x;
      asm volatile("" : "+v"(tss));
      const int tid = tss, lane = tss & 63, wave = tss >> 6, fr = lane & 15, fq = lane >> 4;
      (void)lane;
      const int r0 = bid * 16;
      f32x4 a8[8];
#pragma unroll
      for (int i = 0; i < 8; ++i) a8[i] = (f32x4){0.f, 0.f, 0.f, 0.f};
      const bf16_t* ap = p.O_s + (long)(r0 + fr) * 1024 + fq * 8;
#pragma unroll 2
      for (int ks = 0; ks < 32; ++ks) {
        const bf16x8 af = *(const bf16x8*)(ap + ks * 32);
#pragma unroll
        for (int i = 0; i < 8; ++i) {
          const int nb = 8 * wave + i;
          const bf16x8 bf = *(const bf16x8*)(p.WoutT + (long)((nb >> 2) * 64 + (nb & 3) * 16 + fr) * 1024 + fq * 8 + ks * 32);
          a8[i] = __builtin_amdgcn_mfma_f32_16x16x32_bf16(af, bf, a8[i], 0, 0, 0);
        }
      }
      float ssq[4] = {0.f, 0.f, 0.f, 0.f};
#pragma unroll
      for (int i = 0; i < 8; ++i) {
        const int nb = 8 * wave + i, col = (nb >> 2) * 64 + 4 * fr + (nb & 3);
#pragma unroll
        for (int j = 0; j < 4; ++j) {
          const float v = a8[i][j] + p.x_s[(long)(r0 + fq * 4 + j) * 1024 + col];
          a8[i][j] = v;
          ssq[j] += v * v;
        }
      }
#pragma unroll
      for (int j = 0; j < 4; ++j) {
#pragma unroll
        for (int o = 8; o >= 1; o >>= 1) ssq[j] += __shfl_xor(ssq[j], o);
      }
      __syncthreads();
      if (fr == 0) {
#pragma unroll
        for (int j = 0; j < 4; ++j) red[wave * 16 + fq * 4 + j] = ssq[j];
      }
      __syncthreads();
      if (tid < 16) {
        float t = 0.f;
#pragma unroll
        for (int w8 = 0; w8 < 8; ++w8) t += red[w8 * 16 + tid];
        rsv[tid] = rsqrtf(t * (1.0f / 1024.0f) + 1e-6f);
      }
      __syncthreads();
#pragma unroll
      for (int i = 0; i < 8; ++i) {
        const int nb = 8 * wave + i, col = (nb >> 2) * 64 + 4 * fr + (nb & 3);
        const float gcol = p.g_fin[col];
#pragma unroll
        for (int j = 0; j < 4; ++j) p.out[O_YS + (long)(r0 + fq * 4 + j) * 1024 + col] = a8[i][j] * rsv[fq * 4 + j] * gcol;
      }
    }
  }
}

extern "C" void kernel_launch(void* const* d_in, const int* in_sizes, int n_in, void* d_out, int out_size, void* d_ws, size_t ws_size,
                              hipStream_t stream) {
  static int grid_blocks = 0;
  if (!grid_blocks) {
    int dev = 0, cus = 0, per_cu = 0;
    (void)hipGetDevice(&dev);
    (void)hipDeviceGetAttribute(&cus, hipDeviceAttributeMultiprocessorCount, dev);
    (void)hipOccupancyMaxActiveBlocksPerMultiprocessor(&per_cu, fwd_megakernel, 512, 0);
    if (per_cu < 1) { fprintf(stderr, "occupancy query reports %d blocks/CU\n", per_cu); per_cu = 1; }
    grid_blocks = cus;
  }
  Params p{};
  p.x_p = (const float*)d_in[0]; p.x_s = (const float*)d_in[1]; p.mem_p = (const float*)d_in[2];
  p.cak = (const float*)d_in[3]; p.cav = (const float*)d_in[4]; p.cbk = (const float*)d_in[5]; p.cbv = (const float*)d_in[6];
  p.cbi = (const float*)d_in[7]; p.cmk = (const float*)d_in[8]; p.cmv = (const float*)d_in[9];
  p.g_mix = (const float*)d_in[10]; p.w_in = (const float*)d_in[11]; p.relb = (const float*)d_in[12];
  p.g_mem = (const float*)d_in[13]; p.w_mem = (const float*)d_in[14]; p.w_out = (const float*)d_in[15]; p.g_fin = (const float*)d_in[16];
  p.out = (float*)d_out;
  char* w = (char*)d_ws;
  size_t off = 0;
  auto take = [&](size_t bytes) { char* r = w + off; off += (bytes + 255) & ~(size_t)255; return r; };
  p.bar = (unsigned*)take((size_t)XCD_BAR_WORDS * 4 + 2048);
  p.ctr = p.bar + XCD_BAR_WORDS + 64;
  p.xcnt = p.bar + XCD_BAR_WORDS + 256;
  p.WinT = (bf16_t*)take((size_t)NPAD * 1024 * 2);
  p.WmemT = (bf16_t*)take((size_t)512 * 1024 * 2);
  p.WoutT = (bf16_t*)take((size_t)1024 * 1024 * 2);
  p.xn_p = (bf16_t*)take((size_t)TP * 1024 * 2);
  p.xn_s = (bf16_t*)take((size_t)TS * 1024 * 2);
  p.memn = (bf16_t*)take((size_t)TM * 1024 * 2);
  p.rope = (float2*)take((size_t)2080 * 32 * 8);
  p.Qa_p = (bf16_t*)take((size_t)TP * 384 * 2);
  p.Ka_p = (bf16_t*)take((size_t)TP * 384 * 2);
  p.Va_p = (bf16_t*)take((size_t)TP * 384 * 2);
  p.Qb_p = (bf16_t*)take((size_t)TP * 384 * 2);
  p.Kb_p = (bf16_t*)take((size_t)TP * 384 * 2);
  p.Vb_p = (bf16_t*)take((size_t)TP * 384 * 2);
  p.Gate_p = (bf16_t*)take((size_t)TP * 1024 * 2);
  p.Qm_p = (bf16_t*)take((size_t)TP * 256 * 2);
  p.Qi_p = (bf16_t*)take((size_t)TP * 256 * 2);
  p.Ki_p = (bf16_t*)take((size_t)TP * 32 * 2);
  p.Wi_p = (float*)take((size_t)TP * 8 * 4);
  p.Mk_p = (bf16_t*)take((size_t)TM * 256 * 2);
  p.Mv_p = (bf16_t*)take((size_t)TM * 256 * 2);
  p.Qa_s = (bf16_t*)take((size_t)TS * 384 * 2);
  p.Ka_s = (bf16_t*)take((size_t)8 * 544 * 384 * 2);
  p.Va_s = (bf16_t*)take((size_t)8 * 544 * 384 * 2);
  p.Qb_s = (bf16_t*)take((size_t)TS * 384 * 2);
  p.Kb_s = (bf16_t*)take((size_t)8 * 4128 * 384 * 2);
  p.Vb_s = (bf16_t*)take((size_t)8 * 4128 * 384 * 2);
  p.Gate_s = (bf16_t*)take((size_t)TS * 1024 * 2);
  p.Qm_s = (bf16_t*)take((size_t)TS * 256 * 2);
  p.Qi_s = (bf16_t*)take((size_t)TS * 256 * 2);
  p.Ki_s = (bf16_t*)take((size_t)8 * 4128 * 32 * 2);
  p.Wi_s = (float*)take((size_t)TS * 8 * 4);
  p.Mk_s = (bf16_t*)take((size_t)8 * 256 * 256 * 2);
  p.Mv_s = (bf16_t*)take((size_t)8 * 256 * 256 * 2);
  p.Mask_p = (unsigned*)take((size_t)TP * MASK_LD_P * 4);
  p.Mask_s = (unsigned*)take((size_t)TS * MASK_LD_S * 4);
  p.O_p = (bf16_t*)take((size_t)TP * 1024 * 2);
  p.O_s = (bf16_t*)take((size_t)TS * 1024 * 2);
  p.xch = (float*)take((size_t)128 * 4 * 256 * 4);
  p.use_cg = 0;
  if (off > ws_size) { fprintf(stderr, "workspace too small: need %zu have %zu\n", off, ws_size); return; }
  (void)hipMemsetAsync(p.bar, 0, (size_t)XCD_BAR_WORDS * 4 + 2048, stream);
  void* args[] = {&p};
  hipError_t e = hipLaunchCooperativeKernel((void*)fwd_megakernel, dim3(grid_blocks), dim3(512), args, 0, stream);
  if (e != hipSuccess) fprintf(stderr, "cooperative launch failed: %s (grid %d)\n", hipGetErrorString(e), grid_blocks);
}
```

```cpp
#include <hip/hip_runtime.h>
#include <hip/hip_cooperative_groups.h>
#include <cstdio>
#include <cstdint>
#include <cmath>
namespace cg = cooperative_groups;

#define DI __device__ __forceinline__
typedef unsigned short bf16_t;
typedef short bf16x8 __attribute__((ext_vector_type(8)));
typedef short s16x4 __attribute__((ext_vector_type(4)));
typedef float f32x4 __attribute__((ext_vector_type(4)));
typedef float f32x16 __attribute__((ext_vector_type(16)));
typedef unsigned u32x4 __attribute__((ext_vector_type(4)));
typedef unsigned u32x2 __attribute__((ext_vector_type(2)));

#ifndef REP0
#define REP0 1
#endif
#ifndef REP4
#define REP4 1
#endif
#ifndef REP1
#define REP1 1
#endif
#ifndef REP2
#define REP2 1
#endif
#ifndef REP3
#define REP3 1
#endif
constexpr int TP = 32768, TS = 256, TM = 4096;
constexpr int NCOL = 3880, NPAD = 4096;
constexpr float LOG2E = 1.4426950408889634f;
constexpr float QSCALE = 0.125f * LOG2E;

constexpr long O_YP = 0;
constexpr long O_YS = O_YP + 33554432L;
constexpr long O_AKP = O_YS + 262144;
constexpr long O_AVP = O_AKP + 3145728;
constexpr long O_BKP = O_AVP + 3145728;
constexpr long O_BVP = O_BKP + 12582912;
constexpr long O_BIP = O_BVP + 12582912;
constexpr long O_MKP = O_BIP + 1048576;
constexpr long O_MVP = O_MKP + 1048576;
constexpr long O_AKS = O_MVP + 1048576;
constexpr long O_AVS = O_AKS + 98304;
constexpr long O_BKS = O_AVS + 98304;
constexpr long O_BVS = O_BKS + 98304;
constexpr long O_BIS = O_BVS + 98304;

constexpr int SC_LD = 4160;
constexpr int MASK_LD_P = 64, MASK_LD_S = 132;
constexpr int SMEM_BYTES = 8 * SC_LD * 4;
constexpr int LDT = 80;
#define LAS __attribute__((address_space(3)))

struct Params {
  const float *x_p, *x_s, *mem_p, *cak, *cav, *cbk, *cbv, *cbi, *cmk, *cmv, *g_mix, *w_in, *relb, *g_mem, *w_mem, *w_out, *g_fin;
  float* out;
  bf16_t *WinT, *WmemT, *WoutT, *xn_p, *xn_s, *memn;
  float2* rope;
  bf16_t *Qa_p, *Ka_p, *Va_p, *Qb_p, *Kb_p, *Vb_p, *Gate_p, *Qm_p, *Qi_p, *Ki_p;
  float* Wi_p;
  bf16_t *Mk_p, *Mv_p;
  bf16_t *Qa_s, *Ka_s, *Va_s, *Qb_s, *Kb_s, *Vb_s, *Gate_s, *Qm_s, *Qi_s, *Ki_s;
  float* Wi_s;
  bf16_t *Mk_s, *Mv_s;
  unsigned *Mask_p, *Mask_s;
  bf16_t *O_p, *O_s;
  float* xch;
  unsigned* xcnt;
  unsigned* bar;
  unsigned* ctr;
  long use_cg;
};

DI unsigned cvt_pk_bf16(float lo, float hi) { unsigned r; asm("v_cvt_pk_bf16_f32 %0, %1, %2" : "=v"(r) : "v"(lo), "v"(hi)); return r; }
DI bf16_t f2bf(float x) { return (bf16_t)(cvt_pk_bf16(x, 0.f) & 0xffffu); }
DI float bf2f(unsigned v) { return __uint_as_float(v << 16); }
DI float wave_sum(float v) {
#pragma unroll
  for (int o = 32; o >= 1; o >>= 1) v += __shfl_xor(v, o);
  return v;
}
DI float silu(float v) { return v * __builtin_amdgcn_rcpf(1.0f + __expf(-v)); }

struct RowPtr { const float* src; const float* g; bf16_t* dst; };
template <int NR>
DI void p0_rownorm(const RowPtr (&rp)[NR], int lane) {
  float4 v[NR][4];
#pragma unroll
  for (int r = 0; r < NR; ++r)
#pragma unroll
    for (int j = 0; j < 4; ++j) {
      const f32x4 t4 = __builtin_nontemporal_load((const f32x4*)(rp[r].src + j * 256 + lane * 4));
      v[r][j] = make_float4(t4.x, t4.y, t4.z, t4.w);
    }
#pragma unroll
  for (int r = 0; r < NR; ++r) {
    float ss = 0.f;
#pragma unroll
    for (int j = 0; j < 4; ++j) ss += v[r][j].x * v[r][j].x + v[r][j].y * v[r][j].y + v[r][j].z * v[r][j].z + v[r][j].w * v[r][j].w;
    ss = wave_sum(ss);
    const float rs = rsqrtf(ss * (1.0f / 1024.0f) + 1e-6f);
#pragma unroll
    for (int j = 0; j < 4; ++j) {
      const float4 gg = *(const float4*)(rp[r].g + j * 256 + lane * 4);
      u32x2 o;
      o.x = cvt_pk_bf16(v[r][j].x * rs * gg.x, v[r][j].y * rs * gg.y);
      o.y = cvt_pk_bf16(v[r][j].z * rs * gg.z, v[r][j].w * rs * gg.w);
      *(u32x2*)(rp[r].dst + j * 256 + lane * 4) = o;
    }
  }
}

DI void p0_convert(const float* __restrict__ src, bf16_t* __restrict__ dst, int nb, long chunk, long dstride, long gtid, long gn) {
  const long c4 = chunk >> 2;
  for (int b = 0; b < nb; ++b) {
    const float* sp = src + b * chunk;
    bf16_t* dp = dst + b * dstride;
    long i = gtid;
    for (; i + 7 * gn < c4; i += 8 * gn) {
      float4 v[8];
#pragma unroll
      for (int k = 0; k < 8; ++k) v[k] = *(const float4*)(sp + (i + k * gn) * 4);
#pragma unroll
      for (int k = 0; k < 8; ++k) {
        u32x2 o;
        o.x = cvt_pk_bf16(v[k].x, v[k].y);
        o.y = cvt_pk_bf16(v[k].z, v[k].w);
        *(u32x2*)(dp + (i + k * gn) * 4) = o;
      }
    }
    for (; i < c4; i += gn) {
      const float4 v = *(const float4*)(sp + i * 4);
      u32x2 o;
      o.x = cvt_pk_bf16(v.x, v.y);
      o.y = cvt_pk_bf16(v.z, v.w);
      *(u32x2*)(dp + i * 4) = o;
    }
  }
}

DI void p0_transpose_w(const float* __restrict__ src, int N, int Kdim, bf16_t* __restrict__ dst, int tk, int tn, float* sm, bool valid, int t) {
  const int k0 = tk * 64, n0 = tn * 64;
  if (valid) {
#pragma unroll
    for (int i = 0; i < 16; ++i) {
      const int k = (t >> 6) + 4 * i, n = n0 + (t & 63);
      sm[k * 65 + (t & 63)] = (n < N) ? src[(long)(k0 + k) * N + n] : 0.f;
    }
  }
  __syncthreads();
  if (valid) {
#pragma unroll
    for (int i = 0; i < 8; ++i) {
      const int n = (t >> 5) + 8 * i, k = (t & 31) * 2;
      const unsigned u = cvt_pk_bf16(sm[k * 65 + n], sm[(k + 1) * 65 + n]);
      const int nperm = (n & 3) * 16 + (n >> 2);
      *(unsigned*)(dst + (long)(n0 + nperm) * Kdim + k0 + k) = u;
    }
  }
  __syncthreads();
}

template <int KS> DI int lds_byte(int r, int c) {
  const int st = (r >> 4) * KS + (c >> 5), ob = (r & 15) * 64 + (c & 31) * 2;
  return st * 1024 + (ob ^ (((ob >> 9) & 1) << 5));
}
template <int KS> DI void stage_rc(int b, int& R, int& C) {
  const int st = b >> 10, sb = b & 1023, swz = sb ^ (((sb >> 9) & 1) << 5);
  R = (st / KS) * 16 + swz / 64;
  C = (st % KS) * 32 + (swz % 64) / 2;
}
#define WAIT_V(n) asm volatile("s_waitcnt vmcnt(%0)" ::"n"(n) : "memory")
#define SCHED() __builtin_amdgcn_sched_barrier(0)

DI void gemm256(const bf16_t* __restrict__ A, const bf16_t* __restrict__ Bt, int K, int brow, int bcol, char* sb0, char* sb1, f32x4 (&acc)[8][4]) {
  constexpr int BK = 64, KS = 2, TILE_B = 256 * BK * 2, GL = TILE_B / 8192;
  int tid = threadIdx.x;
  asm volatile("" : "+v"(tid));
  const int wid = tid >> 6, lane = tid & 63, wr = wid >> 2, wc = wid & 3, fr = lane & 15, fq = lane >> 4;
  const bf16_t* Ab = A + (long)brow * K;
  const bf16_t* Bb = Bt + (long)bcol * K;
#define GLDS_STAGE(sb, kt) do { const char* ag_ = (const char*)Ab + (kt) * (BK * 2); const char* bg_ = (const char*)Bb + (kt) * (BK * 2);  \
    int t2_ = tid; asm volatile("" : "+v"(t2_));                                                                                          \
    _Pragma("unroll") for (int i = 0; i < GL; ++i) { int R_, C_; stage_rc<KS>((t2_ >> 6) * 1024 + i * 8192 + (t2_ & 63) * 16, R_, C_);     \
    const unsigned so_ = (unsigned)(R_ * K + C_) * 2u;                                                                                   \
    __builtin_amdgcn_global_load_lds((const unsigned*)(ag_ + so_), (LAS unsigned*)((LAS char*)(sb) + wid * 1024 + i * 8192), 16, 0, 0);          \
    __builtin_amdgcn_global_load_lds((const unsigned*)(bg_ + so_), (LAS unsigned*)((LAS char*)(sb) + TILE_B + wid * 1024 + i * 8192), 16, 0, 0); } } while (0)
#pragma unroll
  for (int m = 0; m < 8; ++m)
#pragma unroll
    for (int n = 0; n < 4; ++n) acc[m][n] = (f32x4){0.f, 0.f, 0.f, 0.f};
#define KSTEP(sb, ks) do { bf16x8 At[4], Bf[4];                                                                      \
    _Pragma("unroll") for (int n = 0; n < 4; ++n) Bf[n] = *(const bf16x8*)((sb) + TILE_B + lds_byte<KS>(wc * 64 + n * 16 + fr, (ks) * 32 + fq * 8)); \
    _Pragma("unroll") for (int mh = 0; mh < 2; ++mh) {                                                                  \
      _Pragma("unroll") for (int m = 0; m < 4; ++m) At[m] = *(const bf16x8*)((sb) + lds_byte<KS>(wr * 128 + (mh * 4 + m) * 16 + fr, (ks) * 32 + fq * 8)); \
      _Pragma("unroll") for (int m = 0; m < 4; ++m) _Pragma("unroll") for (int n = 0; n < 4; ++n)                        \
        acc[mh * 4 + m][n] = __builtin_amdgcn_mfma_f32_16x16x32_bf16(At[m], Bf[n], acc[mh * 4 + m][n], 0, 0, 0);       \
    } SCHED(); } while (0)
#define COMPUTE(sb) do { _Pragma("unroll") for (int ks = 0; ks < KS; ++ks) KSTEP(sb, ks); } while (0)
  const int nt = K / BK;
  __syncthreads();
  GLDS_STAGE(sb0, 0); WAIT_V(0); __syncthreads();
  for (int t = 0; t < nt; t += 2) {
    GLDS_STAGE(sb1, t + 1);
    COMPUTE(sb0);
    WAIT_V(0); __syncthreads();
    if (t + 2 < nt) GLDS_STAGE(sb0, t + 2);
    COMPUTE(sb1);
    WAIT_V(0); __syncthreads();
  }
}

#define ROWLOOP8 _Pragma("unroll") for (int m = 0; m < 8; ++m) _Pragma("unroll") for (int j = 0; j < 4; ++j)
DI void st_bf4(bf16_t* p, float a, float b, float c, float d) { u32x2 o; o.x = cvt_pk_bf16(a, b); o.y = cvt_pk_bf16(c, d); *(u32x2*)p = o; }
DI void st_f4(float* p, float a, float b, float c, float d) { *(float4*)p = make_float4(a, b, c, d); }

template <bool SAMPLE>
DI void epi_mix8(const Params& p, f32x4 (&acc)[8][4], int R0, int cgc, int lane) {
  if (cgc >= 3904) return;
  asm volatile("" : "+v"(lane));
  const int fr = lane & 15, fq = lane >> 4;
  int seg, segoff;
  if (cgc < 3072) { seg = cgc / 384; segoff = cgc - seg * 384; }
  else if (cgc < 3328) { seg = 8; segoff = cgc - 3072; }
  else if (cgc < 3584) { seg = 9; segoff = cgc - 3328; }
  else if (cgc < 3840) { seg = 10; segoff = cgc - 3584; }
  else { seg = 11; segoff = 0; }
  const int c0 = segoff + 4 * fr;
  float* out = p.out;
#define ROWINFO                                                                                   \
  SCHED();                                                                                        \
  const int R = R0 + m * 16 + fq * 4 + j;                                                         \
  const int bb = SAMPLE ? (R >> 5) : (R >> 11);                                                   \
  const int tt = SAMPLE ? (R & 31) : (R & 2047);                                                  \
  const long rowA = SAMPLE ? (long)(bb * 544 + 512 + tt) : (long)R;                               \
  const long rowB = SAMPLE ? (long)(bb * 4128 + 4096 + tt) : (long)R;                             \
  const int rrow = SAMPLE ? (2048 + tt) : tt;                                                     \
  const float v0 = acc[m][0][j], v1 = acc[m][1][j], v2 = acc[m][2][j], v3 = acc[m][3][j];        \
  (void)bb; (void)tt; (void)rowA; (void)rowB; (void)rrow;
#define ROPE64                                                                                    \
  if ((j & 1) == 0) {                                                                             \
    _Pragma("unroll") for (int jj = 0; jj < 2; ++jj) {                                            \
      csA[jj] = *(const float4*)(p.rope + (rrow + jj) * 32 + 4 * (fr & 7));                       \
      csB[jj] = *(const float4*)(p.rope + (rrow + jj) * 32 + 4 * (fr & 7) + 2); } }               \
  const float4 csa = csA[j & 1], csb = csB[j & 1];                                                       \
  const float x0 = __shfl_xor(v0, 8), x1 = __shfl_xor(v1, 8), x2 = __shfl_xor(v2, 8), x3 = __shfl_xor(v3, 8); \
  const float sg = (fr < 8) ? -1.f : 1.f;                                                         \
  const float y0 = v0 * csa.x + sg * x0 * csa.y, y1 = v1 * csa.z + sg * x1 * csa.w;               \
  const float y2 = v2 * csb.x + sg * x2 * csb.y, y3 = v3 * csb.z + sg * x3 * csb.w;
#define ROPE32                                                                                    \
  if ((j & 1) == 0) {                                                                             \
    _Pragma("unroll") for (int jj = 0; jj < 2; ++jj)                                              \
      _Pragma("unroll") for (int q = 0; q < 4; ++q) c32[jj][q] = p.rope[(rrow + jj) * 32 + 8 * (fr & 3) + 2 * q]; } \
  const float2 ca = c32[j & 1][0], cb = c32[j & 1][1], cc = c32[j & 1][2], cd = c32[j & 1][3];                   \
  const float x0 = __shfl_xor(v0, 4), x1 = __shfl_xor(v1, 4), x2 = __shfl_xor(v2, 4), x3 = __shfl_xor(v3, 4); \
  const float sg = (fr & 4) ? 1.f : -1.f;                                                         \
  const float y0 = v0 * ca.x + sg * x0 * ca.y, y1 = v1 * cb.x + sg * x1 * cb.y;                   \
  const float y2 = v2 * cc.x + sg * x2 * cc.y, y3 = v3 * cd.x + sg * x3 * cd.y;
  switch (seg) {
    case 0: {
      bf16_t* dst = SAMPLE ? p.Qa_s : p.Qa_p;
      ROWLOOP8 { ROWINFO st_bf4(dst + (long)R * 384 + c0, v0 * QSCALE, v1 * QSCALE, v2 * QSCALE, v3 * QSCALE); }
    } break;
    case 8: {
      bf16_t* dst = SAMPLE ? p.Qm_s : p.Qm_p;
      ROWLOOP8 { ROWINFO st_bf4(dst + (long)R * 256 + c0, v0 * QSCALE, v1 * QSCALE, v2 * QSCALE, v3 * QSCALE); }
    } break;
    case 4: {
      bf16_t* dst = SAMPLE ? p.Qb_s : p.Qb_p;
      float4 csA[2], csB[2];
      ROWLOOP8 { ROWINFO ROPE64 st_bf4(dst + (long)R * 384 + c0, y0 * QSCALE, y1 * QSCALE, y2 * QSCALE, y3 * QSCALE); }
    } break;
    case 1: case 2: {
      bf16_t* dst = (seg == 1) ? (SAMPLE ? p.Ka_s : p.Ka_p) : (SAMPLE ? p.Va_s : p.Va_p);
      float* o = out + (SAMPLE ? (seg == 1 ? O_AKS : O_AVS) : (seg == 1 ? O_AKP : O_AVP));
      ROWLOOP8 { ROWINFO
        st_bf4(dst + rowA * 384 + c0, v0, v1, v2, v3);
        if (SAMPLE) st_f4(o + (long)R * 384 + c0, v0, v1, v2, v3);
        else if (tt >= 1536) st_f4(o + ((long)bb * 512 + (tt - 1536)) * 384 + c0, v0, v1, v2, v3);
      }
    } break;
    case 5: {
      bf16_t* dst = SAMPLE ? p.Kb_s : p.Kb_p;
      float* o = out + (SAMPLE ? O_BKS : O_BKP);
      float4 csA[2], csB[2];
      ROWLOOP8 { ROWINFO ROPE64
        st_bf4(dst + rowB * 384 + c0, y0, y1, y2, y3);
        st_f4(o + (long)R * 384 + c0, y0, y1, y2, y3);
      }
    } break;
    case 6: {
      bf16_t* dst = SAMPLE ? p.Vb_s : p.Vb_p;
      float* o = out + (SAMPLE ? O_BVS : O_BVP);
      ROWLOOP8 { ROWINFO
        st_bf4(dst + rowB * 384 + c0, v0, v1, v2, v3);
        st_f4(o + (long)R * 384 + c0, v0, v1, v2, v3);
      }
    } break;
    case 3: case 7: case 9: {
      bf16_t* dst = (SAMPLE ? p.Gate_s : p.Gate_p) + (seg == 3 ? 0 : (seg == 7 ? 384 : 768));
      ROWLOOP8 { ROWINFO st_bf4(dst + (long)R * 1024 + c0, silu(v0), silu(v1), silu(v2), silu(v3)); }
    } break;
    case 10: {
      bf16_t* dst = SAMPLE ? p.Qi_s : p.Qi_p;
      float2 c32[2][4];
      ROWLOOP8 { ROWINFO ROPE32 st_bf4(dst + (long)R * 256 + c0, y0, y1, y2, y3); }
    } break;
    default: {
      bf16_t* dst = SAMPLE ? p.Ki_s : p.Ki_p;
      float* o = out + (SAMPLE ? O_BIS : O_BIP);
      float* wdst = SAMPLE ? p.Wi_s : p.Wi_p;
      float2 c32[2][4];
      ROWLOOP8 { ROWINFO ROPE32
        if (fr < 8) { st_bf4(dst + rowB * 32 + 4 * fr, y0, y1, y2, y3); st_f4(o + (long)R * 32 + 4 * fr, y0, y1, y2, y3); }
        else if (fr < 10) st_f4(wdst + (long)R * 8 + 4 * (fr - 8), v0 * 0.0625f, v1 * 0.0625f, v2 * 0.0625f, v3 * 0.0625f);
      }
    } break;
  }
#undef ROWINFO
#undef ROPE64
#undef ROPE32
}

DI void tr8(unsigned addr, s16x4& l0, s16x4& l1, s16x4& l2, s16x4& l3, s16x4& h0, s16x4& h1, s16x4& h2, s16x4& h3) {
  asm volatile(
      "ds_read_b64_tr_b16 %0, %8\n\t"
      "ds_read_b64_tr_b16 %1, %8 offset:32\n\t"
      "ds_read_b64_tr_b16 %2, %8 offset:64\n\t"
      "ds_read_b64_tr_b16 %3, %8 offset:96\n\t"
      "ds_read_b64_tr_b16 %4, %8 offset:2560\n\t"
      "ds_read_b64_tr_b16 %5, %8 offset:2592\n\t"
      "ds_read_b64_tr_b16 %6, %8 offset:2624\n\t"
      "ds_read_b64_tr_b16 %7, %8 offset:2656\n\t"
      "s_waitcnt lgkmcnt(0)"
      : "=&v"(l0), "=&v"(l1), "=&v"(l2), "=&v"(l3), "=&v"(h0), "=&v"(h1), "=&v"(h2), "=&v"(h3)
      : "v"(addr)
      : "memory");
}

template <int MODE, bool F32KV = false>
DI void attn8(const bf16_t* __restrict__ Q, int ldq, int nq, const bf16_t* __restrict__ Kg, const bf16_t* __restrict__ Vg,
              int ldk, int nkeys, int tlo0, int thi0, int tlo1, int thi1, const bf16_t* __restrict__ gate, bf16_t* __restrict__ O,
              const float* __restrict__ biasg, int rel00, int rel01, const unsigned* __restrict__ maskg, int mask_ld, char* smem,
              const float* __restrict__ Kf = nullptr, const float* __restrict__ Vf = nullptr, int nf32t = 0) {
  bf16_t* sK = (bf16_t*)smem;
  bf16_t* sV = sK + 64 * LDT;
  float* sb = (float*)(sV + 64 * LDT);
  int tid = threadIdx.x;
  asm volatile("" : "+v"(tid));
  const int lane = tid & 63, wave = tid >> 6, c = lane & 15, g = lane >> 4;
  const int hf = wave >> 2, w4 = wave & 3;
  const int qin = w4 * 16 + c;
  const int qrow = hf * 64 + qin;
  const int qrc = qrow < nq ? qrow : nq - 1;
  const bool wactive = (hf * 64 + w4 * 16) < nq;
  const int tlo = hf ? tlo1 : tlo0, thi = hf ? thi1 : thi0, rel0 = hf ? rel01 : rel00;
  const int tbeg = tlo0 < tlo1 ? tlo0 : tlo1, tend = thi0 > thi1 ? thi0 : thi1;
  bf16x8 qB[2];
  qB[0] = *(const bf16x8*)(Q + (long)qrc * ldq + g * 8);
  qB[1] = *(const bf16x8*)(Q + (long)qrc * ldq + 32 + g * 8);
  __syncthreads();
  if (MODE == 1) {
    for (int i = tid; i < 513; i += 512) sb[i] = biasg[i] * LOG2E;
  }
  f32x4 o[4];
#pragma unroll
  for (int dt = 0; dt < 4; ++dt) o[dt] = (f32x4){0.f, 0.f, 0.f, 0.f};
  float m_run = -INFINITY, l_part = 0.f;
  const int skey = tid >> 3, sc16 = tid & 7;
  u32x4 aK0, aK1, aV0, aV1, bK0, bK1, bV0, bV1;
  aK1 = aV1 = bK1 = bV1 = (u32x4){0u, 0u, 0u, 0u};
  auto load_tile = [&](const int tile, u32x4& rk0, u32x4& rk1, u32x4& rv0, u32x4& rv1) __attribute__((always_inline)) {
    int key = tile * 64 + skey;
    key = key < nkeys ? key : nkeys - 1;
    if (F32KV && tile < nf32t) {
      const float* kp = Kf + (long)key * ldk + sc16 * 8;
      const float* vp = Vf + (long)key * ldk + sc16 * 8;
      rk0 = *(const u32x4*)kp; rk1 = *(const u32x4*)(kp + 4);
      rv0 = *(const u32x4*)vp; rv1 = *(const u32x4*)(vp + 4);
    } else {
      rk0 = *(const u32x4*)(Kg + (long)key * ldk + sc16 * 8);
      rv0 = *(const u32x4*)(Vg + (long)key * ldk + sc16 * 8);
    }
  };
  auto pack8 = [&](const u32x4& a, const u32x4& b) __attribute__((always_inline)) {
    u32x4 o;
    o.x = cvt_pk_bf16(__uint_as_float(a.x), __uint_as_float(a.y));
    o.y = cvt_pk_bf16(__uint_as_float(a.z), __uint_as_float(a.w));
    o.z = cvt_pk_bf16(__uint_as_float(b.x), __uint_as_float(b.y));
    o.w = cvt_pk_bf16(__uint_as_float(b.z), __uint_as_float(b.w));
    return o;
  };
  load_tile(tbeg, aK0, aK1, aV0, aV1);
  load_tile(tbeg + 1, bK0, bK1, bV0, bV1);
  const unsigned vaddr0 = (unsigned)(size_t)sV + (unsigned)((4 * g + (c >> 2)) * (LDT * 2) + (c & 3) * 8);
  u32x2 mwn = (u32x2){0u, 0u}, mwn2 = (u32x2){0u, 0u};
  if (MODE == 2) mwn2 = *(const u32x2*)(maskg + (long)qrc * mask_ld + tbeg * 2);
  auto step = [&](const int tile, u32x4& rk0, u32x4& rk1, u32x4& rv0, u32x4& rv1) __attribute__((always_inline)) {
    __syncthreads();
    if (F32KV && tile < nf32t) {
      *(u32x4*)(sK + skey * LDT + sc16 * 8) = pack8(rk0, rk1);
      *(u32x4*)(sV + skey * LDT + sc16 * 8) = pack8(rv0, rv1);
    } else {
      *(u32x4*)(sK + skey * LDT + sc16 * 8) = rk0;
      *(u32x4*)(sV + skey * LDT + sc16 * 8) = rv0;
    }
    __syncthreads();
    if (tile + 2 < tend) load_tile(tile + 2, rk0, rk1, rv0, rv1);
    if (MODE == 2) { mwn = mwn2; if (tile + 1 < tend) mwn2 = *(const u32x2*)(maskg + (long)qrc * mask_ld + (tile + 1) * 2); }
    if (wactive && tile >= tlo && tile < thi) {
      f32x4 s[4];
#pragma unroll
      for (int t = 0; t < 4; ++t) {
        s[t] = (f32x4){0.f, 0.f, 0.f, 0.f};
#pragma unroll
        for (int kb = 0; kb < 2; ++kb) {
          const bf16x8 kf = *(const bf16x8*)(sK + (16 * t + c) * LDT + kb * 32 + g * 8);
          s[t] = __builtin_amdgcn_mfma_f32_16x16x32_bf16(kf, qB[kb], s[t], 0, 0, 0);
        }
      }
      const int kbase = tile * 64 + 4 * g;
      if (MODE == 1) {
#pragma unroll
        for (int t = 0; t < 4; ++t)
#pragma unroll
          for (int i = 0; i < 4; ++i) {
            int d = rel0 + qin - (kbase + 16 * t + i);
            d = d < -256 ? -256 : (d > 256 ? 256 : d);
            s[t][i] += sb[d + 256];
          }
      }
      if (MODE == 2) {
        const u32x2 mw = mwn;
#pragma unroll
        for (int t = 0; t < 4; ++t) {
          const unsigned w = (t >> 1) ? mw.y : mw.x;
#pragma unroll
          for (int i = 0; i < 4; ++i) {
            const int bit = (t & 1) * 16 + 4 * g + i;
            if (!((w >> bit) & 1u)) s[t][i] = -INFINITY;
          }
        }
      }
      if (tile * 64 + 64 > nkeys) {
#pragma unroll
        for (int t = 0; t < 4; ++t)
#pragma unroll
          for (int i = 0; i < 4; ++i)
            if (kbase + 16 * t + i >= nkeys) s[t][i] = -INFINITY;
      }
      float mx = -INFINITY;
#pragma unroll
      for (int t = 0; t < 4; ++t)
#pragma unroll
        for (int i = 0; i < 4; ++i) mx = fmaxf(mx, s[t][i]);
      mx = fmaxf(mx, __shfl_xor(mx, 16));
      mx = fmaxf(mx, __shfl_xor(mx, 32));
      const float m_new = fmaxf(m_run, mx);
      const float m_safe = (m_new == -INFINITY) ? 0.f : m_new;
      const float alpha = __builtin_amdgcn_exp2f(m_run - m_safe);
      m_run = m_new;
      float psum = 0.f;
#pragma unroll
      for (int t = 0; t < 4; ++t)
#pragma unroll
        for (int i = 0; i < 4; ++i) {
          s[t][i] = __builtin_amdgcn_exp2f(s[t][i] - m_safe);
          psum += s[t][i];
        }
      l_part = l_part * alpha + psum;
#pragma unroll
      for (int dt = 0; dt < 4; ++dt)
#pragma unroll
        for (int i = 0; i < 4; ++i) o[dt][i] *= alpha;
#pragma unroll
      for (int kb2 = 0; kb2 < 2; ++kb2) {
        u32x4 pk;
        pk.x = cvt_pk_bf16(s[2 * kb2][0], s[2 * kb2][1]);
        pk.y = cvt_pk_bf16(s[2 * kb2][2], s[2 * kb2][3]);
        pk.z = cvt_pk_bf16(s[2 * kb2 + 1][0], s[2 * kb2 + 1][1]);
        pk.w = cvt_pk_bf16(s[2 * kb2 + 1][2], s[2 * kb2 + 1][3]);
        const bf16x8 pB = __builtin_bit_cast(bf16x8, pk);
        s16x4 lo[4], hi[4];
        tr8(vaddr0 + kb2 * 32 * (LDT * 2), lo[0], lo[1], lo[2], lo[3], hi[0], hi[1], hi[2], hi[3]);
#pragma unroll
        for (int dt = 0; dt < 4; ++dt) {
          const bf16x8 vf = __builtin_shufflevector(lo[dt], hi[dt], 0, 1, 2, 3, 4, 5, 6, 7);
          o[dt] = __builtin_amdgcn_mfma_f32_16x16x32_bf16(vf, pB, o[dt], 0, 0, 0);
        }
      }
    }
  };
  for (int tile = tbeg; tile < tend; tile += 2) {
    step(tile, aK0, aK1, aV0, aV1);
    if (tile + 1 < tend) step(tile + 1, bK0, bK1, bV0, bV1);
  }
  float l = l_part;
  l += __shfl_xor(l, 16);
  l += __shfl_xor(l, 32);
  const float inv = 1.0f / l;
  if (qrow < nq) {
#pragma unroll
    for (int dt = 0; dt < 4; ++dt) {
      const int d0 = 16 * dt + 4 * g;
      const u32x2 gg = *(const u32x2*)(gate + (long)qrow * 1024 + d0);
      u32x2 ov;
      ov.x = cvt_pk_bf16(o[dt][0] * inv * bf2f(gg.x & 0xffffu), o[dt][1] * inv * bf2f(gg.x >> 16));
      ov.y = cvt_pk_bf16(o[dt][2] * inv * bf2f(gg.y & 0xffffu), o[dt][3] * inv * bf2f(gg.y >> 16));
      *(u32x2*)(O + (long)qrow * 1024 + d0) = ov;
    }
  }
}

template <int NJ>
DI void select_query(const unsigned* sc, int N, unsigned* __restrict__ maskrow, int lane) {
  unsigned u[NJ];
#pragma unroll
  for (int j = 0; j < NJ; ++j) {
    const int idx = 64 * j + lane;
    u[j] = idx < N ? sc[idx] : 0u;
  }
  unsigned T = (N > 256) ? 0u : 1u;
  if (N > 256) {
    for (int bit = 31; bit >= 0; --bit) {
      const unsigned cand = T | (1u << bit);
      int cnt = 0;
#pragma unroll
      for (int j = 0; j < NJ; ++j) cnt += __popcll(__ballot(u[j] >= cand));
      if (cnt >= 256) { T = cand; if (cnt == 256) break; }
    }
  }
  int cgt = 0;
#pragma unroll
  for (int j = 0; j < NJ; ++j) cgt += __popcll(__ballot(u[j] > T));
  const int need = 256 - cgt;
  int running = 0;
#pragma unroll
  for (int j = 0; j < NJ; ++j) {
    const unsigned long long eq = __ballot(u[j] == T);
    const int rank = running + (int)__builtin_amdgcn_mbcnt_hi((unsigned)(eq >> 32), __builtin_amdgcn_mbcnt_lo((unsigned)eq, 0u));
    const bool sel = (u[j] > T) || (u[j] == T && rank < need);
    const unsigned long long sm = __ballot(sel);
    running += __popcll(eq);
    if (lane == 0) {
      u32x2 w;
      w.x = (unsigned)sm;
      w.y = (unsigned)(sm >> 32);
      *(u32x2*)(maskrow + 2 * j) = w;
    }
  }
}
DI void select_item8(const bf16_t* __restrict__ Qi, const float* __restrict__ Wi, long q0, const bf16_t* __restrict__ Ki, int N,
                     unsigned* __restrict__ maskbase, int mask_ld, char* smemA, char* smemB) {
  int tid = threadIdx.x;
  asm volatile("" : "+v"(tid));
  const int lane = tid & 63, wave = tid >> 6, r = lane & 31, hh = lane >> 5;
  const int hf = wave >> 2, w4 = wave & 3;
  unsigned* sc = (unsigned*)(hf ? smemB : smemA);
  const long qb = q0 + hf * 4;
  const int qsel = 2 * ((r >> 2) & 1) + (r >> 4), head = 4 * ((r >> 3) & 1) + (r & 3);
  bf16x8 a[2];
  a[0] = *(const bf16x8*)(Qi + (qb + qsel) * 256 + head * 32 + hh * 8);
  a[1] = *(const bf16x8*)(Qi + (qb + qsel) * 256 + head * 32 + 16 + hh * 8);
  float w[2][8];
#pragma unroll
  for (int qq = 0; qq < 2; ++qq) {
    const float4 w0 = *(const float4*)(Wi + (qb + 2 * hh + qq) * 8);
    const float4 w1 = *(const float4*)(Wi + (qb + 2 * hh + qq) * 8 + 4);
    w[qq][0] = w0.x; w[qq][1] = w0.y; w[qq][2] = w0.z; w[qq][3] = w0.w;
    w[qq][4] = w1.x; w[qq][5] = w1.y; w[qq][6] = w1.z; w[qq][7] = w1.w;
  }
  __syncthreads();
  const int ntile = (N + 31) >> 5;
  for (int nt = w4; nt < ntile; nt += 4) {
    const int key = nt * 32 + r;
    const int keyc = key < N ? key : N - 1;
    const bf16x8 b0 = *(const bf16x8*)(Ki + (long)keyc * 32 + hh * 8);
    const bf16x8 b1 = *(const bf16x8*)(Ki + (long)keyc * 32 + 16 + hh * 8);
    f32x16 acc;
#pragma unroll
    for (int i = 0; i < 16; ++i) acc[i] = 0.f;
    acc = __builtin_amdgcn_mfma_f32_32x32x16_bf16(a[0], b0, acc, 0, 0, 0);
    acc = __builtin_amdgcn_mfma_f32_32x32x16_bf16(a[1], b1, acc, 0, 0, 0);
#pragma unroll
    for (int qq = 0; qq < 2; ++qq) {
      float s = 0.f;
#pragma unroll
      for (int h = 0; h < 8; ++h) s += w[qq][h] * fmaxf(acc[8 * qq + h], 0.f);
      unsigned ub = __float_as_uint(s);
      ub = (ub & 0x80000000u) ? ~ub : (ub | 0x80000000u);
      if (key < N) sc[(2 * hh + qq) * SC_LD + key] = ub;
    }
  }
  __syncthreads();
  const unsigned* row = sc + w4 * SC_LD;
  unsigned* mrow = maskbase + (long)wave * mask_ld;
  if (N <= 512) select_query<8>(row, N, mrow, lane);
  else if (N <= 1024) select_query<16>(row, N, mrow, lane);
  else if (N <= 1536) select_query<24>(row, N, mrow, lane);
  else if (N <= 2048) select_query<32>(row, N, mrow, lane);
  else select_query<65>(row, N, mrow, lane);
}


#define XB_TMO      128
#define XB_XCNT(j)  (256  + 64 * (j))
#define XB_XSUB(j)  (1280 + 64 * (j))
#define XB_XGEN(j)  (2304 + 64 * (j))
#define XB_TOP      3328
#define XB_TOPGEN   3392
#define XCD_BAR_WORDS 3456
#define XB_SPIN_CAP (1u << 22)
DI unsigned xb_ld(unsigned* p) { return __hip_atomic_load(p, __ATOMIC_RELAXED, __HIP_MEMORY_SCOPE_AGENT); }
DI unsigned xb_add(unsigned* p, unsigned v) { return __hip_atomic_fetch_add(p, v, __ATOMIC_RELAXED, __HIP_MEMORY_SCOPE_AGENT); }
DI unsigned xb_xcc_id() { return (unsigned)__builtin_amdgcn_s_getreg((3 << 11) | 20) & 0xFu; }
#define XB_SPIN(cond, bar) do { unsigned _sp = 0; while (cond) { __builtin_amdgcn_s_sleep(1); \
    if ((++_sp & 255u) == 0u) { if (xb_ld(&(bar)[XB_TMO])) break; if (_sp > XB_SPIN_CAP) { atomicAdd(&(bar)[XB_TMO], 1u); break; } } } } while (0)
struct XcdBarrier { unsigned* bar; unsigned x; volatile LAS unsigned* st; };
DI XcdBarrier xcd_barrier_post(unsigned* bar, volatile LAS unsigned* st) {
  XcdBarrier b; b.bar = bar; b.x = xb_xcc_id(); b.st = st;
  if (threadIdx.x == 0) (void)xb_add(&bar[XB_XCNT(b.x)], 1u);
  return b;
}
DI void xcd_barrier_complete(unsigned* bar, unsigned x, unsigned& nloc, unsigned& nx) {
  const unsigned G = gridDim.x * gridDim.y * gridDim.z;
  unsigned sum, cnt, mine, sp = 0u;
  for (;;) {
    sum = 0u; cnt = 0u; mine = 0u;
#pragma unroll
    for (unsigned j = 0; j < 16; ++j) { const unsigned c = xb_ld(&bar[XB_XCNT(j)]); sum += c; cnt += (c > 0u) ? 1u : 0u; mine = (j == x) ? c : mine; }
    if (sum == G) break;
    __builtin_amdgcn_s_sleep(1);
    if ((++sp & 255u) == 0u) { if (xb_ld(&bar[XB_TMO])) break; if (sp > XB_SPIN_CAP) { atomicAdd(&bar[XB_TMO], 1u); break; } }
  }
  nloc = mine > 0u ? mine : 1u; nx = cnt > 0u ? cnt : 1u;
}
DI void xcd_barrier(const XcdBarrier& b) {
  asm volatile("s_waitcnt vmcnt(0)" ::: "memory");
  __syncthreads();
  if (threadIdx.x == 0) {
    unsigned* bar = b.bar;
    __builtin_amdgcn_s_waitcnt(0);
    unsigned nloc = b.st[0], nx = b.st[1];
    if (nloc == 0u) { xcd_barrier_complete(bar, b.x, nloc, nx); b.st[0] = nloc; b.st[1] = nx; }
    const unsigned old = xb_add(&bar[XB_XSUB(b.x)], 1u);
    const unsigned gen = old / nloc;
    if (old + 1u == (gen + 1u) * nloc) {
      __builtin_amdgcn_fence(__ATOMIC_RELEASE, "agent");
      asm volatile("s_waitcnt vmcnt(0)" ::: "memory");
      const unsigned og = xb_add(&bar[XB_TOP], 1u);
      const unsigned tg = og / nx;
      if (og + 1u == (tg + 1u) * nx) xb_add(&bar[XB_TOPGEN], 1u);
      else XB_SPIN(xb_ld(&bar[XB_TOPGEN]) == tg, bar);
      __builtin_amdgcn_fence(__ATOMIC_ACQUIRE, "agent");
      xb_add(&bar[XB_XGEN(b.x)], 1u);
      asm volatile("s_waitcnt vmcnt(0)" ::: "memory");
    } else {
      XB_SPIN(xb_ld(&bar[XB_XGEN(b.x)]) == gen, bar);
      __builtin_amdgcn_fence(__ATOMIC_ACQUIRE, "agent");
      asm volatile("s_waitcnt vmcnt(0)" ::: "memory");
    }
  }
  __syncthreads();
}

__global__ void __launch_bounds__(512, 2) fwd_megakernel(Params p) {
  cg::grid_group grid = cg::this_grid();
  __shared__ __attribute__((aligned(1024))) char smemA[SMEM_BYTES / 2];
  __shared__ __attribute__((aligned(1024))) char smemB[SMEM_BYTES / 2];
  char* const smem = smemA;
  __shared__ uint4 xb_words;
  __shared__ int s_next;
  const int tid = threadIdx.x, lane = tid & 63, wave = tid >> 6;
  const int nblk = gridDim.x, bid = blockIdx.x;
  if (tid == 0) xb_words = make_uint4(0u, 0u, 0u, 0u);
  __syncthreads();
  const XcdBarrier xb = xcd_barrier_post(p.bar, (volatile LAS unsigned*)&xb_words);
  if (p.use_cg) grid.sync();

  for (int rep0 = 0; rep0 < REP0; ++rep0) {
    const int half = tid >> 8, t = tid & 255;
    float* smf = (float*)smem + half * (64 * 65);
    for (int base = bid * 2; base < 1024 + 128 + 256; base += nblk * 2) {
      const int it = base + half;
      const bool valid = it < 1408;
      if (it < 1024) p0_transpose_w(p.w_in, NCOL, 1024, p.WinT, it >> 6, it & 63, smf, valid, t);
      else if (it < 1152) { const int j = it - 1024; p0_transpose_w(p.w_mem, 512, 1024, p.WmemT, j >> 3, j & 7, smf, valid, t); }
      else { const int j = (valid ? it : 1407) - 1152; p0_transpose_w(p.w_out, 1024, 1024, p.WoutT, j >> 4, j & 15, smf, valid, t); }
    }
    {
      const int nrows = TP + TS + TM, stride = nblk * 8;
      auto rowptr = [&](int row) {
        RowPtr r;
        if (row < TP) { r.src = p.x_p + (long)row * 1024; r.g = p.g_mix; r.dst = p.xn_p + (long)row * 1024; }
        else if (row < TP + TS) { const int r2 = row - TP; r.src = p.x_s + (long)r2 * 1024; r.g = p.g_mix; r.dst = p.xn_s + (long)r2 * 1024; }
        else { const int r2 = row - TP - TS; r.src = p.mem_p + (long)r2 * 1024; r.g = p.g_mem; r.dst = p.memn + (long)r2 * 1024; }
        return r;
      };
      int row = bid * 8 + wave;
      for (; row + 3 * stride < nrows; row += 4 * stride) {
        const RowPtr rp[4] = {rowptr(row), rowptr(row + stride), rowptr(row + 2 * stride), rowptr(row + 3 * stride)};
        p0_rownorm<4>(rp, lane);
      }
      for (; row < nrows; row += stride) {
        const RowPtr rp[1] = {rowptr(row)};
        p0_rownorm<1>(rp, lane);
      }
    }
    const long gtid = (long)bid * 512 + tid, gn = (long)nblk * 512;
    p0_convert(p.cak, p.Ka_s, 8, 512L * 384, 544L * 384, gtid, gn);
    p0_convert(p.cav, p.Va_s, 8, 512L * 384, 544L * 384, gtid, gn);
    p0_convert(p.cbi, p.Ki_s, 8, 4096L * 32, 4128L * 32, gtid, gn);
    p0_convert(p.cmk, p.Mk_s, 1, 8L * 256 * 256, 0, gtid, gn);
    p0_convert(p.cmv, p.Mv_s, 1, 8L * 256 * 256, 0, gtid, gn);
    for (long i = gtid; i < 2080 * 32; i += gn) {
      const int pr = (int)(i >> 5), k = (int)(i & 31);
      const int pos = pr < 2048 ? pr : (4096 + pr - 2048);
      const float invf = (float)exp2((double)k * -0.41524101186092029);
      const float ang = (float)pos * invf;
      double rev = (double)ang * 0.15915494309189533577;
      rev = rev - rint(rev);
      const float fr = (float)rev;
      p.rope[i] = make_float2(__builtin_amdgcn_cosf(fr), __builtin_amdgcn_sinf(fr));
    }
  }
  xcd_barrier(xb);

  {
    for (int round9 = 0; round9 < 9 * REP1; ++round9)
      for (int vb = bid; vb < 256; vb += nblk) {
        const int round = round9 % 9;
        int kind, gm, gn;
        if (round < 8) {
          const int xcd = vb & 7, slot = vb >> 3;
          kind = 0; gm = (round * 4 + (xcd >> 1)) * 4 + (slot & 3); gn = ((xcd + round) & 1) * 8 + (((slot >> 2) + round) & 7);
        } else if (vb < 16) { kind = 1; gm = 0; gn = vb; }
        else if (vb < 48) { kind = 2; gm = (vb - 16) >> 1; gn = (vb - 16) & 1; }
        else continue;
        const bf16_t* Ap = kind == 0 ? p.xn_p : (kind == 1 ? p.xn_s : p.memn);
        const bf16_t* Bp = kind == 2 ? p.WmemT : p.WinT;
        f32x4 acc[8][4];
        gemm256(Ap, Bp, 1024, gm * 256, gn * 256, smemA, smemB, acc);
        int tq = threadIdx.x;
        asm volatile("" : "+v"(tq));
        const int lane = tq & 63, wr = tq >> 8, wc = (tq >> 6) & 3;
        const int R0 = gm * 256 + wr * 128, cgc = gn * 256 + wc * 64;
        if (kind == 0) epi_mix8<false>(p, acc, R0, cgc, lane);
        else if (kind == 1) epi_mix8<true>(p, acc, R0, cgc, lane);
        else {
          const bool isv = cgc >= 256;
          bf16_t* dst = isv ? p.Mv_p : p.Mk_p;
          float* o = p.out + (isv ? O_MVP : O_MKP);
          const int cc = (cgc & 255) + 4 * (lane & 15);
          ROWLOOP8 {
            SCHED();
            const int R = R0 + m * 16 + (lane >> 4) * 4 + j;
            st_bf4(dst + (long)R * 256 + cc, acc[m][0][j], acc[m][1][j], acc[m][2][j], acc[m][3][j]);
            st_f4(o + (long)R * 256 + cc, acc[m][0][j], acc[m][1][j], acc[m][2][j], acc[m][3][j]);
          }
        }
      }
  }
  xcd_barrier(xb);

#define QUEUE_BEGIN(ctrp, total)                                              \
  { unsigned* _ctr = (ctrp); const int _total = (total);                     \
    __syncthreads();                                                          \
    if (tid == 0) s_next = (int)atomicAdd(_ctr, 1u);                          \
    __syncthreads();                                                          \
    int it = s_next;                                                          \
    while (it < _total) {                                                     \
      int _nxt = 0;                                                           \
      if (tid == 0) _nxt = (int)atomicAdd(_ctr, 1u);
#define QUEUE_END                                                             \
      __syncthreads();                                                        \
      if (tid == 0) s_next = _nxt;                                            \
      __syncthreads();                                                        \
      it = s_next;                                                            \
    } }

  {
    const int e0 = 32, e1 = e0 + 48, e2 = e1 + 32, e3 = e2 + 4096, e4 = e3 + 1536, e5 = e4 + 1024;
    QUEUE_BEGIN(p.ctr, REP2 * e5)
      const int iq = it % e5;
      if (iq < e0) {
        const int b = iq >> 2, qg = iq & 3;
        const long q0 = (long)b * 32 + qg * 8;
        select_item8(p.Qi_s, p.Wi_s, q0, p.Ki_s + (long)b * 4128 * 32, 4128, p.Mask_s + q0 * MASK_LD_S, MASK_LD_S, smemA, smemB);
      } else if (iq < e1) {
        const int j = iq - e0, b = j / 6, h = j % 6;
        attn8<1>(p.Qa_s + (long)b * 32 * 384 + h * 64, 384, 32, p.Ka_s + (long)b * 544 * 384 + h * 64, p.Va_s + (long)b * 544 * 384 + h * 64,
                 384, 544, 0, 9, 0, 0, p.Gate_s + (long)b * 32 * 1024 + h * 64, p.O_s + (long)b * 32 * 1024 + h * 64, p.relb + h * 513, 512, 0,
                 nullptr, 0, smem);
      } else if (iq < e2) {
        const int j = iq - e1, b = j >> 2, h = j & 3;
        attn8<0>(p.Qm_s + (long)b * 32 * 256 + h * 64, 256, 32, p.Mk_s + (long)b * 65536 + h * 64, p.Mv_s + (long)b * 65536 + h * 64, 256, 256,
                 0, 4, 0, 0, p.Gate_s + (long)b * 32 * 1024 + 768 + h * 64, p.O_s + (long)b * 32 * 1024 + 768 + h * 64, nullptr, 0, 0, nullptr, 0,
                 smem);
      } else if (iq < e3) {
        const int j = iq - e2, c = 31 - (j >> 7), rem = j & 127, b = rem >> 3, qg = rem & 7;
        const long q0 = (long)b * 2048 + c * 64 + qg * 8;
        select_item8(p.Qi_p, p.Wi_p, q0, p.Ki_p + (long)b * 2048 * 32, (c + 1) * 64, p.Mask_p + q0 * MASK_LD_P, MASK_LD_P, smemA, smemB);
      } else if (iq < e4) {
        const int j = iq - e3, b = j / 96, cp = (j / 6) & 15, h = j % 6;
        const int c0 = 2 * cp, c1 = c0 + 1, kb0 = c0 > 8 ? c0 - 8 : 0, k0 = kb0 * 64;
        const long row0 = (long)b * 2048 + c0 * 64, krow = (long)b * 2048 + k0;
        attn8<1>(p.Qa_p + row0 * 384 + h * 64, 384, 128, p.Ka_p + krow * 384 + h * 64, p.Va_p + krow * 384 + h * 64, 384, (c1 + 1) * 64 - k0,
                 0, c0 - kb0 + 1, (c1 > 8 ? c1 - 8 : 0) - kb0, c1 - kb0 + 1, p.Gate_p + row0 * 1024 + h * 64, p.O_p + row0 * 1024 + h * 64,
                 p.relb + h * 513, c0 * 64 - k0, c1 * 64 - k0, nullptr, 0, smem);
      } else {
        const int j = iq - e4, b = j >> 6, cp = (j >> 2) & 15, h = j & 3;
        const long row0 = (long)b * 2048 + cp * 128;
        attn8<0>(p.Qm_p + row0 * 256 + h * 64, 256, 128, p.Mk_p + (long)b * 65536 + h * 64, p.Mv_p + (long)b * 65536 + h * 64, 256, 256, 0, 4, 0, 4,
                 p.Gate_p + row0 * 1024 + 768 + h * 64, p.O_p + row0 * 1024 + 768 + h * 64, nullptr, 0, 0, nullptr, 0, smem);
      }
    QUEUE_END
  }
  xcd_barrier(xb);

  {
    const int nB_s = 48, nB_p = 1536;
    QUEUE_BEGIN(p.ctr + 64, REP3 * (nB_s + nB_p))
      const int iq = it % (nB_s + nB_p);
      if (iq < nB_s) {
        const int b = iq / 6, h = iq % 6;
        attn8<2, true>(p.Qb_s + (long)b * 32 * 384 + h * 64, 384, 32, p.Kb_s + (long)b * 4128 * 384 + h * 64, p.Vb_s + (long)b * 4128 * 384 + h * 64,
                 384, 4128, 0, 65, 0, 0, p.Gate_s + (long)b * 32 * 1024 + 384 + h * 64, p.O_s + (long)b * 32 * 1024 + 384 + h * 64, nullptr, 0, 0,
                 p.Mask_s + (long)b * 32 * MASK_LD_S, MASK_LD_S, smem, p.cbk + (long)b * 4096 * 384 + h * 64, p.cbv + (long)b * 4096 * 384 + h * 64, 64);
      } else {
        const int j = iq - nB_s, cp = 15 - j / 96, rem = j % 96, b = rem / 6, h = rem % 6;
        const int c0 = 2 * cp, c1 = c0 + 1;
        const long row0 = (long)b * 2048 + c0 * 64;
        attn8<2>(p.Qb_p + row0 * 384 + h * 64, 384, 128, p.Kb_p + (long)b * 2048 * 384 + h * 64, p.Vb_p + (long)b * 2048 * 384 + h * 64, 384,
                 (c1 + 1) * 64, 0, c0 + 1, 0, c1 + 1, p.Gate_p + row0 * 1024 + 384 + h * 64, p.O_p + row0 * 1024 + 384 + h * 64, nullptr, 0, 0,
                 p.Mask_p + row0 * MASK_LD_P, MASK_LD_P, smem);
      }
    QUEUE_END
  }
  xcd_barrier(xb);

  {
    const int wr = wave >> 2, wc = wave & 3, fr = lane & 15, fq = lane >> 4;
    float* red = (float*)smem;
    float* red2 = (float*)smem;
    float* rsv = (float*)smemB;
    for (int round = 0; round < 2; ++round)
      for (int vb = bid; vb < 256; vb += nblk) {
        const int gm = round * 64 + (vb & 7) * 8 + ((vb >> 3) & 7), gn = vb >> 6;
        f32x4 acc[8][4];
        gemm256(p.O_p, p.WoutT, 1024, gm * 256, gn * 256, smemA, smemB, acc);
        int tq = threadIdx.x;
        asm volatile("" : "+v"(tq));
        const int ln = tq & 63, wv = tq >> 6, wr = wv >> 2, wc = wv & 3;
        const int fr2 = ln & 15, fq2 = ln >> 4;
        const int R0 = gm * 256 + wr * 128, C0 = gn * 256 + wc * 64 + 4 * fr2;
        float4 xq[2][4];
#pragma unroll
        for (int jj = 0; jj < 4; ++jj) xq[0][jj] = *(const float4*)(p.x_p + (long)(gm * 256 + wr * 128 + fq2 * 4 + jj) * 1024 + C0);
        ROWLOOP8 {
          SCHED();
          const int rl = wr * 128 + m * 16 + fq2 * 4 + j;
          if (j == 0 && m < 7) {
#pragma unroll
            for (int jj = 0; jj < 4; ++jj) xq[(m + 1) & 1][jj] = *(const float4*)(p.x_p + (long)(gm * 256 + wr * 128 + (m + 1) * 16 + fq2 * 4 + jj) * 1024 + C0);
          }
          const float4 xv = xq[m & 1][j];
          const float v0 = acc[m][0][j] + xv.x, v1 = acc[m][1][j] + xv.y, v2 = acc[m][2][j] + xv.z, v3 = acc[m][3][j] + xv.w;
          acc[m][0][j] = v0; acc[m][1][j] = v1; acc[m][2][j] = v2; acc[m][3][j] = v3;
          red2[rl * 65 + wc * 16 + fr2] = v0 * v0 + v1 * v1 + v2 * v2 + v3 * v3;
        }
        __syncthreads();
        if (tq < 256) {
          float mine = 0.f;
#pragma unroll 16
          for (int q = 0; q < 64; ++q) mine += red2[tq * 65 + q];
          __hip_atomic_store(p.xch + (long)(gm * 4 + gn) * 256 + tq, mine, __ATOMIC_RELAXED, __HIP_MEMORY_SCOPE_AGENT);
        }
        asm volatile("s_waitcnt vmcnt(0)" ::: "memory");
        __syncthreads();
        if (tq == 0) {
          (void)__hip_atomic_fetch_add(p.xcnt + gm, 1u, __ATOMIC_RELAXED, __HIP_MEMORY_SCOPE_AGENT);
          unsigned sp = 0;
          while (__hip_atomic_load(p.xcnt + gm, __ATOMIC_RELAXED, __HIP_MEMORY_SCOPE_AGENT) < 4u) {
            __builtin_amdgcn_s_sleep(1);
            if (++sp > (1u << 22)) break;
          }
        }
        __syncthreads();
        if (tq < 256) {
          float t = 0.f;
#pragma unroll
          for (int g4 = 0; g4 < 4; ++g4) t += __hip_atomic_load(p.xch + (long)(gm * 4 + g4) * 256 + tq, __ATOMIC_RELAXED, __HIP_MEMORY_SCOPE_AGENT);
          rsv[tq] = rsqrtf(t * (1.0f / 1024.0f) + 1e-6f);
        }
        __syncthreads();
        const float4 gf = *(const float4*)(p.g_fin + C0);
        int fq3 = fq2;
        asm volatile("" : "+v"(fq3));
        ROWLOOP8 {
          SCHED();
          const int rl = wr * 128 + m * 16 + fq3 * 4 + j;
          const float rs = rsv[rl];
          st_f4(p.out + O_YP + (long)(gm * 256 + rl) * 1024 + C0, acc[m][0][j] * rs * gf.x, acc[m][1][j] * rs * gf.y, acc[m][2][j] * rs * gf.z,
                acc[m][3][j] * rs * gf.w);
        }
      }
    __syncthreads();
    if (bid < 16) {
      int tss = threadIdx.x;
      asm volatile("" : "+v"(tss));
      const int tid = tss, lane = tss & 63, wave = tss >> 6, fr = lane & 15, fq = lane >> 4;
      (void)lane;
      const int r0 = bid * 16;
      f32x4 a8[8];
#pragma unroll
      for (int i = 0; i < 8; ++i) a8[i] = (f32x4){0.f, 0.f, 0.f, 0.f};
      const bf16_t* ap = p.O_s + (long)(r0 + fr) * 1024 + fq * 8;
#pragma unroll 2
      for (int ks = 0; ks < 32; ++ks) {
        const bf16x8 af = *(const bf16x8*)(ap + ks * 32);
#pragma unroll
        for (int i = 0; i < 8; ++i) {
          const int nb = 8 * wave + i;
          const bf16x8 bf = *(const bf16x8*)(p.WoutT + (long)((nb >> 2) * 64 + (nb & 3) * 16 + fr) * 1024 + fq * 8 + ks * 32);
          a8[i] = __builtin_amdgcn_mfma_f32_16x16x32_bf16(af, bf, a8[i], 0, 0, 0);
        }
      }
      float ssq[4] = {0.f, 0.f, 0.f, 0.f};
#pragma unroll
      for (int i = 0; i < 8; ++i) {
        const int nb = 8 * wave + i, col = (nb >> 2) * 64 + 4 * fr + (nb & 3);
#pragma unroll
        for (int j = 0; j < 4; ++j) {
          const float v = a8[i][j] + p.x_s[(long)(r0 + fq * 4 + j) * 1024 + col];
          a8[i][j] = v;
          ssq[j] += v * v;
        }
      }
#pragma unroll
      for (int j = 0; j < 4; ++j) {
#pragma unroll
        for (int o = 8; o >= 1; o >>= 1) ssq[j] += __shfl_xor(ssq[j], o);
      }
      __syncthreads();
      if (fr == 0) {
#pragma unroll
        for (int j = 0; j < 4; ++j) red[wave * 16 + fq * 4 + j] = ssq[j];
      }
      __syncthreads();
      if (tid < 16) {
        float t = 0.f;
#pragma unroll
        for (int w8 = 0; w8 < 8; ++w8) t += red[w8 * 16 + tid];
        rsv[tid] = rsqrtf(t * (1.0f / 1024.0f) + 1e-6f);
      }
      __syncthreads();
#pragma unroll
      for (int i = 0; i < 8; ++i) {
        const int nb = 8 * wave + i, col = (nb >> 2) * 64 + 4 * fr + (nb & 3);
        const float gcol = p.g_fin[col];
#pragma unroll
        for (int j = 0; j < 4; ++j) p.out[O_YS + (long)(r0 + fq * 4 + j) * 1024 + col] = a8[i][j] * rsv[fq * 4 + j] * gcol;
      }
    }
  }
}

extern "C" void kernel_launch(void* const* d_in, const int* in_sizes, int n_in, void* d_out, int out_size, void* d_ws, size_t ws_size,
                              hipStream_t stream) {
  static int grid_blocks = 0;
  if (!grid_blocks) {
    int dev = 0, cus = 0, per_cu = 0;
    (void)hipGetDevice(&dev);
    (void)hipDeviceGetAttribute(&cus, hipDeviceAttributeMultiprocessorCount, dev);
    (void)hipOccupancyMaxActiveBlocksPerMultiprocessor(&per_cu, fwd_megakernel, 512, 0);
    if (per_cu < 1) { fprintf(stderr, "occupancy query reports %d blocks/CU\n", per_cu); per_cu = 1; }
    grid_blocks = cus;
  }
  Params p{};
  p.x_p = (const float*)d_in[0]; p.x_s = (const float*)d_in[1]; p.mem_p = (const float*)d_in[2];
  p.cak = (const float*)d_in[3]; p.cav = (const float*)d_in[4]; p.cbk = (const float*)d_in[5]; p.cbv = (const float*)d_in[6];
  p.cbi = (const float*)d_in[7]; p.cmk = (const float*)d_in[8]; p.cmv = (const float*)d_in[9];
  p.g_mix = (const float*)d_in[10]; p.w_in = (const float*)d_in[11]; p.relb = (const float*)d_in[12];
  p.g_mem = (const float*)d_in[13]; p.w_mem = (const float*)d_in[14]; p.w_out = (const float*)d_in[15]; p.g_fin = (const float*)d_in[16];
  p.out = (float*)d_out;
  char* w = (char*)d_ws;
  size_t off = 0;
  auto take = [&](size_t bytes) { char* r = w + off; off += (bytes + 255) & ~(size_t)255; return r; };
  p.bar = (unsigned*)take((size_t)XCD_BAR_WORDS * 4 + 2048);
  p.ctr = p.bar + XCD_BAR_WORDS + 64;
  p.xcnt = p.bar + XCD_BAR_WORDS + 256;
  p.WinT = (bf16_t*)take((size_t)NPAD * 1024 * 2);
  p.WmemT = (bf16_t*)take((size_t)512 * 1024 * 2);
  p.WoutT = (bf16_t*)take((size_t)1024 * 1024 * 2);
  p.xn_p = (bf16_t*)take((size_t)TP * 1024 * 2);
  p.xn_s = (bf16_t*)take((size_t)TS * 1024 * 2);
  p.memn = (bf16_t*)take((size_t)TM * 1024 * 2);
  p.rope = (float2*)take((size_t)2080 * 32 * 8);
  p.Qa_p = (bf16_t*)take((size_t)TP * 384 * 2);
  p.Ka_p = (bf16_t*)take((size_t)TP * 384 * 2);
  p.Va_p = (bf16_t*)take((size_t)TP * 384 * 2);
  p.Qb_p = (bf16_t*)take((size_t)TP * 384 * 2);
  p.Kb_p = (bf16_t*)take((size_t)TP * 384 * 2);
  p.Vb_p = (bf16_t*)take((size_t)TP * 384 * 2);
  p.Gate_p = (bf16_t*)take((size_t)TP * 1024 * 2);
  p.Qm_p = (bf16_t*)take((size_t)TP * 256 * 2);
  p.Qi_p = (bf16_t*)take((size_t)TP * 256 * 2);
  p.Ki_p = (bf16_t*)take((size_t)TP * 32 * 2);
  p.Wi_p = (float*)take((size_t)TP * 8 * 4);
  p.Mk_p = (bf16_t*)take((size_t)TM * 256 * 2);
  p.Mv_p = (bf16_t*)take((size_t)TM * 256 * 2);
  p.Qa_s = (bf16_t*)take((size_t)TS * 384 * 2);
  p.Ka_s = (bf16_t*)take((size_t)8 * 544 * 384 * 2);
  p.Va_s = (bf16_t*)take((size_t)8 * 544 * 384 * 2);
  p.Qb_s = (bf16_t*)take((size_t)TS * 384 * 2);
  p.Kb_s = (bf16_t*)take((size_t)8 * 4128 * 384 * 2);
  p.Vb_s = (bf16_t*)take((size_t)8 * 4128 * 384 * 2);
  p.Gate_s = (bf16_t*)take((size_t)TS * 1024 * 2);
  p.Qm_s = (bf16_t*)take((size_t)TS * 256 * 2);
  p.Qi_s = (bf16_t*)take((size_t)TS * 256 * 2);
  p.Ki_s = (bf16_t*)take((size_t)8 * 4128 * 32 * 2);
  p.Wi_s = (float*)take((size_t)TS * 8 * 4);
  p.Mk_s = (bf16_t*)take((size_t)8 * 256 * 256 * 2);
  p.Mv_s = (bf16_t*)take((size_t)8 * 256 * 256 * 2);
  p.Mask_p = (unsigned*)take((size_t)TP * MASK_LD_P * 4);
  p.Mask_s = (unsigned*)take((size_t)TS * MASK_LD_S * 4);
  p.O_p = (bf16_t*)take((size_t)TP * 1024 * 2);
  p.O_s = (bf16_t*)take((size_t)TS * 1024 * 2);
  p.xch = (float*)take((size_t)128 * 4 * 256 * 4);
  p.use_cg = 0;
  if (off > ws_size) { fprintf(stderr, "workspace too small: need %zu have %zu\n", off, ws_size); return; }
  (void)hipMemsetAsync(p.bar, 0, (size_t)XCD_BAR_WORDS * 4 + 2048, stream);
  void* args[] = {&p};
  hipError_t e = hipLaunchCooperativeKernel((void*)fwd_megakernel, dim3(grid_blocks), dim3(512), args, 0, stream);
  if (e != hipSuccess) fprintf(stderr, "cooperative launch failed: %s (grid %d)\n", hipGetErrorString(e), grid_blocks);
}
```

```cpp
#include <hip/hip_runtime.h>
#include <hip/hip_cooperative_groups.h>
#include <cstdio>
#include <cstdint>
#include <cmath>
namespace cg = cooperative_groups;

#define DI __device__ __forceinline__
typedef unsigned short bf16_t;
typedef short bf16x8 __attribute__((ext_vector_type(8)));
typedef short s16x4 __attribute__((ext_vector_type(4)));
typedef float f32x4 __attribute__((ext_vector_type(4)));
typedef float f32x16 __attribute__((ext_vector_type(16)));
typedef unsigned u32x4 __attribute__((ext_vector_type(4)));
typedef unsigned u32x2 __attribute__((ext_vector_type(2)));

#ifndef REP0
#define REP0 1
#endif
#ifndef REP4
#define REP4 1
#endif
#ifndef REP1
#define REP1 1
#endif
#ifndef REP2
#define REP2 1
#endif
#ifndef REP3
#define REP3 1
#endif
constexpr int TP = 32768, TS = 256, TM = 4096;
constexpr int NCOL = 3880, NPAD = 4096;
constexpr float LOG2E = 1.4426950408889634f;
constexpr float QSCALE = 0.125f * LOG2E;

constexpr long O_YP = 0;
constexpr long O_YS = O_YP + 33554432L;
constexpr long O_AKP = O_YS + 262144;
constexpr long O_AVP = O_AKP + 3145728;
constexpr long O_BKP = O_AVP + 3145728;
constexpr long O_BVP = O_BKP + 12582912;
constexpr long O_BIP = O_BVP + 12582912;
constexpr long O_MKP = O_BIP + 1048576;
constexpr long O_MVP = O_MKP + 1048576;
constexpr long O_AKS = O_MVP + 1048576;
constexpr long O_AVS = O_AKS + 98304;
constexpr long O_BKS = O_AVS + 98304;
constexpr long O_BVS = O_BKS + 98304;
constexpr long O_BIS = O_BVS + 98304;

constexpr int SC_LD = 4160;
constexpr int MASK_LD_P = 64, MASK_LD_S = 132;
constexpr int SMEM_BYTES = 8 * SC_LD * 4;
constexpr int LDT = 80;
#define LAS __attribute__((address_space(3)))

struct Params {
  const float *x_p, *x_s, *mem_p, *cak, *cav, *cbk, *cbv, *cbi, *cmk, *cmv, *g_mix, *w_in, *relb, *g_mem, *w_mem, *w_out, *g_fin;
  float* out;
  bf16_t *WinT, *WmemT, *WoutT, *xn_p, *xn_s, *memn;
  float2* rope;
  bf16_t *Qa_p, *Ka_p, *Va_p, *Qb_p, *Kb_p, *Vb_p, *Gate_p, *Qm_p, *Qi_p, *Ki_p;
  float* Wi_p;
  bf16_t *Mk_p, *Mv_p;
  bf16_t *Qa_s, *Ka_s, *Va_s, *Qb_s, *Kb_s, *Vb_s, *Gate_s, *Qm_s, *Qi_s, *Ki_s;
  float* Wi_s;
  bf16_t *Mk_s, *Mv_s;
  unsigned *Mask_p, *Mask_s;
  bf16_t *O_p, *O_s;
  float* xch;
  unsigned* xcnt;
  unsigned* bar;
  unsigned* ctr;
  long use_cg;
};

DI unsigned cvt_pk_bf16(float lo, float hi) { unsigned r; asm("v_cvt_pk_bf16_f32 %0, %1, %2" : "=v"(r) : "v"(lo), "v"(hi)); return r; }
DI bf16_t f2bf(float x) { return (bf16_t)(cvt_pk_bf16(x, 0.f) & 0xffffu); }
DI float bf2f(unsigned v) { return __uint_as_float(v << 16); }
DI float wave_sum(float v) {
#pragma unroll
  for (int o = 32; o >= 1; o >>= 1) v += __shfl_xor(v, o);
  return v;
}
DI float silu(float v) { return v * __builtin_amdgcn_rcpf(1.0f + __expf(-v)); }

struct RowPtr { const float* src; const float* g; bf16_t* dst; };
template <int NR>
DI void p0_rownorm(const RowPtr (&rp)[NR], int lane) {
  float4 v[NR][4];
#pragma unroll
  for (int r = 0; r < NR; ++r)
#pragma unroll
    for (int j = 0; j < 4; ++j) {
      const f32x4 t4 = __builtin_nontemporal_load((const f32x4*)(rp[r].src + j * 256 + lane * 4));
      v[r][j] = make_float4(t4.x, t4.y, t4.z, t4.w);
    }
#pragma unroll
  for (int r = 0; r < NR; ++r) {
    float ss = 0.f;
#pragma unroll
    for (int j = 0; j < 4; ++j) ss += v[r][j].x * v[r][j].x + v[r][j].y * v[r][j].y + v[r][j].z * v[r][j].z + v[r][j].w * v[r][j].w;
    ss = wave_sum(ss);
    const float rs = rsqrtf(ss * (1.0f / 1024.0f) + 1e-6f);
#pragma unroll
    for (int j = 0; j < 4; ++j) {
      const float4 gg = *(const float4*)(rp[r].g + j * 256 + lane * 4);
      u32x2 o;
      o.x = cvt_pk_bf16(v[r][j].x * rs * gg.x, v[r][j].y * rs * gg.y);
      o.y = cvt_pk_bf16(v[r][j].z * rs * gg.z, v[r][j].w * rs * gg.w);
      *(u32x2*)(rp[r].dst + j * 256 + lane * 4) = o;
    }
  }
}

DI void p0_convert(const float* __restrict__ src, bf16_t* __restrict__ dst, int nb, long chunk, long dstride, long gtid, long gn) {
  const long c4 = chunk >> 2;
  for (int b = 0; b < nb; ++b) {
    const float* sp = src + b * chunk;
    bf16_t* dp = dst + b * dstride;
    long i = gtid;
    for (; i + 7 * gn < c4; i += 8 * gn) {
      float4 v[8];
#pragma unroll
      for (int k = 0; k < 8; ++k) v[k] = *(const float4*)(sp + (i + k * gn) * 4);
#pragma unroll
      for (int k = 0; k < 8; ++k) {
        u32x2 o;
        o.x = cvt_pk_bf16(v[k].x, v[k].y);
        o.y = cvt_pk_bf16(v[k].z, v[k].w);
        *(u32x2*)(dp + (i + k * gn) * 4) = o;
      }
    }
    for (; i < c4; i += gn) {
      const float4 v = *(const float4*)(sp + i * 4);
      u32x2 o;
      o.x = cvt_pk_bf16(v.x, v.y);
      o.y = cvt_pk_bf16(v.z, v.w);
      *(u32x2*)(dp + i * 4) = o;
    }
  }
}

DI void p0_transpose_w(const float* __restrict__ src, int N, int Kdim, bf16_t* __restrict__ dst, int tk, int tn, float* sm, bool valid, int t) {
  const int k0 = tk * 64, n0 = tn * 64;
  if (valid) {
#pragma unroll
    for (int i = 0; i < 16; ++i) {
      const int k = (t >> 6) + 4 * i, n = n0 + (t & 63);
      sm[k * 65 + (t & 63)] = (n < N) ? src[(long)(k0 + k) * N + n] : 0.f;
    }
  }
  __syncthreads();
  if (valid) {
#pragma unroll
    for (int i = 0; i < 8; ++i) {
      const int n = (t >> 5) + 8 * i, k = (t & 31) * 2;
      const unsigned u = cvt_pk_bf16(sm[k * 65 + n], sm[(k + 1) * 65 + n]);
      const int nperm = (n & 3) * 16 + (n >> 2);
      *(unsigned*)(dst + (long)(n0 + nperm) * Kdim + k0 + k) = u;
    }
  }
  __syncthreads();
}

template <int KS> DI int lds_byte(int r, int c) {
  const int st = (r >> 4) * KS + (c >> 5), ob = (r & 15) * 64 + (c & 31) * 2;
  return st * 1024 + (ob ^ (((ob >> 9) & 1) << 5));
}
template <int KS> DI void stage_rc(int b, int& R, int& C) {
  const int st = b >> 10, sb = b & 1023, swz = sb ^ (((sb >> 9) & 1) << 5);
  R = (st / KS) * 16 + swz / 64;
  C = (st % KS) * 32 + (swz % 64) / 2;
}
#define WAIT_V(n) asm volatile("s_waitcnt vmcnt(%0)" ::"n"(n) : "memory")
#define SCHED() __builtin_amdgcn_sched_barrier(0)

DI void gemm256(const bf16_t* __restrict__ A, const bf16_t* __restrict__ Bt, int K, int brow, int bcol, char* sb0, char* sb1, f32x4 (&acc)[8][4]) {
  constexpr int BK = 64, KS = 2, TILE_B = 256 * BK * 2, GL = TILE_B / 8192;
  int tid = threadIdx.x;
  asm volatile("" : "+v"(tid));
  const int wid = tid >> 6, lane = tid & 63, wr = wid >> 2, wc = wid & 3, fr = lane & 15, fq = lane >> 4;
  const bf16_t* Ab = A + (long)brow * K;
  const bf16_t* Bb = Bt + (long)bcol * K;
#define GLDS_STAGE(sb, kt) do { const char* ag_ = (const char*)Ab + (kt) * (BK * 2); const char* bg_ = (const char*)Bb + (kt) * (BK * 2);  \
    int t2_ = tid; asm volatile("" : "+v"(t2_));                                                                                          \
    _Pragma("unroll") for (int i = 0; i < GL; ++i) { int R_, C_; stage_rc<KS>((t2_ >> 6) * 1024 + i * 8192 + (t2_ & 63) * 16, R_, C_);     \
    const unsigned so_ = (unsigned)(R_ * K + C_) * 2u;                                                                                   \
    __builtin_amdgcn_global_load_lds((const unsigned*)(ag_ + so_), (LAS unsigned*)((LAS char*)(sb) + wid * 1024 + i * 8192), 16, 0, 0);          \
    __builtin_amdgcn_global_load_lds((const unsigned*)(bg_ + so_), (LAS unsigned*)((LAS char*)(sb) + TILE_B + wid * 1024 + i * 8192), 16, 0, 0); } } while (0)
#pragma unroll
  for (int m = 0; m < 8; ++m)
#pragma unroll
    for (int n = 0; n < 4; ++n) acc[m][n] = (f32x4){0.f, 0.f, 0.f, 0.f};
#define KSTEP(sb, ks) do { bf16x8 At[4], Bf[4];                                                                      \
    _Pragma("unroll") for (int n = 0; n < 4; ++n) Bf[n] = *(const bf16x8*)((sb) + TILE_B + lds_byte<KS>(wc * 64 + n * 16 + fr, (ks) * 32 + fq * 8)); \
    _Pragma("unroll") for (int mh = 0; mh < 2; ++mh) {                                                                  \
      _Pragma("unroll") for (int m = 0; m < 4; ++m) At[m] = *(const bf16x8*)((sb) + lds_byte<KS>(wr * 128 + (mh * 4 + m) * 16 + fr, (ks) * 32 + fq * 8)); \
      _Pragma("unroll") for (int m = 0; m < 4; ++m) _Pragma("unroll") for (int n = 0; n < 4; ++n)                        \
        acc[mh * 4 + m][n] = __builtin_amdgcn_mfma_f32_16x16x32_bf16(At[m], Bf[n], acc[mh * 4 + m][n], 0, 0, 0);       \
    } SCHED(); } while (0)
#define COMPUTE(sb) do { _Pragma("unroll") for (int ks = 0; ks < KS; ++ks) KSTEP(sb, ks); } while (0)
  const int nt = K / BK;
  __syncthreads();
  GLDS_STAGE(sb0, 0); WAIT_V(0); __syncthreads();
  for (int t = 0; t < nt; t += 2) {
    GLDS_STAGE(sb1, t + 1);
    COMPUTE(sb0);
    WAIT_V(0); __syncthreads();
    if (t + 2 < nt) GLDS_STAGE(sb0, t + 2);
    COMPUTE(sb1);
    WAIT_V(0); __syncthreads();
  }
}

#define ROWLOOP8 _Pragma("unroll") for (int m = 0; m < 8; ++m) _Pragma("unroll") for (int j = 0; j < 4; ++j)
DI void st_bf4(bf16_t* p, float a, float b, float c, float d) { u32x2 o; o.x = cvt_pk_bf16(a, b); o.y = cvt_pk_bf16(c, d); *(u32x2*)p = o; }
DI void st_f4(float* p, float a, float b, float c, float d) { *(float4*)p = make_float4(a, b, c, d); }

template <bool SAMPLE>
DI void epi_mix8(const Params& p, f32x4 (&acc)[8][4], int R0, int cgc, int lane) {
  if (cgc >= 3904) return;
  asm volatile("" : "+v"(lane));
  const int fr = lane & 15, fq = lane >> 4;
  int seg, segoff;
  if (cgc < 3072) { seg = cgc / 384; segoff = cgc - seg * 384; }
  else if (cgc < 3328) { seg = 8; segoff = cgc - 3072; }
  else if (cgc < 3584) { seg = 9; segoff = cgc - 3328; }
  else if (cgc < 3840) { seg = 10; segoff = cgc - 3584; }
  else { seg = 11; segoff = 0; }
  const int c0 = segoff + 4 * fr;
  float* out = p.out;
#define ROWINFO                                                                                   \
  SCHED();                                                                                        \
  const int R = R0 + m * 16 + fq * 4 + j;                                                         \
  const int bb = SAMPLE ? (R >> 5) : (R >> 11);                                                   \
  const int tt = SAMPLE ? (R & 31) : (R & 2047);                                                  \
  const long rowA = SAMPLE ? (long)(bb * 544 + 512 + tt) : (long)R;                               \
  const long rowB = SAMPLE ? (long)(bb * 4128 + 4096 + tt) : (long)R;                             \
  const int rrow = SAMPLE ? (2048 + tt) : tt;                                                     \
  const float v0 = acc[m][0][j], v1 = acc[m][1][j], v2 = acc[m][2][j], v3 = acc[m][3][j];        \
  (void)bb; (void)tt; (void)rowA; (void)rowB; (void)rrow;
#define ROPE64                                                                                    \
  if ((j & 1) == 0) {                                                                             \
    _Pragma("unroll") for (int jj = 0; jj < 2; ++jj) {                                            \
      csA[jj] = *(const float4*)(p.rope + (rrow + jj) * 32 + 4 * (fr & 7));                       \
      csB[jj] = *(const float4*)(p.rope + (rrow + jj) * 32 + 4 * (fr & 7) + 2); } }               \
  const float4 csa = csA[j & 1], csb = csB[j & 1];                                                       \
  const float x0 = __shfl_xor(v0, 8), x1 = __shfl_xor(v1, 8), x2 = __shfl_xor(v2, 8), x3 = __shfl_xor(v3, 8); \
  const float sg = (fr < 8) ? -1.f : 1.f;                                                         \
  const float y0 = v0 * csa.x + sg * x0 * csa.y, y1 = v1 * csa.z + sg * x1 * csa.w;               \
  const float y2 = v2 * csb.x + sg * x2 * csb.y, y3 = v3 * csb.z + sg * x3 * csb.w;
#define ROPE32                                                                                    \
  if ((j & 1) == 0) {                                                                             \
    _Pragma("unroll") for (int jj = 0; jj < 2; ++jj)                                              \
      _Pragma("unroll") for (int q = 0; q < 4; ++q) c32[jj][q] = p.rope[(rrow + jj) * 32 + 8 * (fr & 3) + 2 * q]; } \
  const float2 ca = c32[j & 1][0], cb = c32[j & 1][1], cc = c32[j & 1][2], cd = c32[j & 1][3];                   \
  const float x0 = __shfl_xor(v0, 4), x1 = __shfl_xor(v1, 4), x2 = __shfl_xor(v2, 4), x3 = __shfl_xor(v3, 4); \
  const float sg = (fr & 4) ? 1.f : -1.f;                                                         \
  const float y0 = v0 * ca.x + sg * x0 * ca.y, y1 = v1 * cb.x + sg * x1 * cb.y;                   \
  const float y2 = v2 * cc.x + sg * x2 * cc.y, y3 = v3 * cd.x + sg * x3 * cd.y;
  switch (seg) {
    case 0: {
      bf16_t* dst = SAMPLE ? p.Qa_s : p.Qa_p;
      ROWLOOP8 { ROWINFO st_bf4(dst + (long)R * 384 + c0, v0 * QSCALE, v1 * QSCALE, v2 * QSCALE, v3 * QSCALE); }
    } break;
    case 8: {
      bf16_t* dst = SAMPLE ? p.Qm_s : p.Qm_p;
      ROWLOOP8 { ROWINFO st_bf4(dst + (long)R * 256 + c0, v0 * QSCALE, v1 * QSCALE, v2 * QSCALE, v3 * QSCALE); }
    } break;
    case 4: {
      bf16_t* dst = SAMPLE ? p.Qb_s : p.Qb_p;
      float4 csA[2], csB[2];
      ROWLOOP8 { ROWINFO ROPE64 st_bf4(dst + (long)R * 384 + c0, y0 * QSCALE, y1 * QSCALE, y2 * QSCALE, y3 * QSCALE); }
    } break;
    case 1: case 2: {
      bf16_t* dst = (seg == 1) ? (SAMPLE ? p.Ka_s : p.Ka_p) : (SAMPLE ? p.Va_s : p.Va_p);
      float* o = out + (SAMPLE ? (seg == 1 ? O_AKS : O_AVS) : (seg == 1 ? O_AKP : O_AVP));
      ROWLOOP8 { ROWINFO
        st_bf4(dst + rowA * 384 + c0, v0, v1, v2, v3);
        if (SAMPLE) st_f4(o + (long)R * 384 + c0, v0, v1, v2, v3);
        else if (tt >= 1536) st_f4(o + ((long)bb * 512 + (tt - 1536)) * 384 + c0, v0, v1, v2, v3);
      }
    } break;
    case 5: {
      bf16_t* dst = SAMPLE ? p.Kb_s : p.Kb_p;
      float* o = out + (SAMPLE ? O_BKS : O_BKP);
      float4 csA[2], csB[2];
      ROWLOOP8 { ROWINFO ROPE64
        st_bf4(dst + rowB * 384 + c0, y0, y1, y2, y3);
        st_f4(o + (long)R * 384 + c0, y0, y1, y2, y3);
      }
    } break;
    case 6: {
      bf16_t* dst = SAMPLE ? p.Vb_s : p.Vb_p;
      float* o = out + (SAMPLE ? O_BVS : O_BVP);
      ROWLOOP8 { ROWINFO
        st_bf4(dst + rowB * 384 + c0, v0, v1, v2, v3);
        st_f4(o + (long)R * 384 + c0, v0, v1, v2, v3);
      }
    } break;
    case 3: case 7: case 9: {
      bf16_t* dst = (SAMPLE ? p.Gate_s : p.Gate_p) + (seg == 3 ? 0 : (seg == 7 ? 384 : 768));
      ROWLOOP8 { ROWINFO st_bf4(dst + (long)R * 1024 + c0, silu(v0), silu(v1), silu(v2), silu(v3)); }
    } break;
    case 10: {
      bf16_t* dst = SAMPLE ? p.Qi_s : p.Qi_p;
      float2 c32[2][4];
      ROWLOOP8 { ROWINFO ROPE32 st_bf4(dst + (long)R * 256 + c0, y0, y1, y2, y3); }
    } break;
    default: {
      bf16_t* dst = SAMPLE ? p.Ki_s : p.Ki_p;
      float* o = out + (SAMPLE ? O_BIS : O_BIP);
      float* wdst = SAMPLE ? p.Wi_s : p.Wi_p;
      float2 c32[2][4];
      ROWLOOP8 { ROWINFO ROPE32
        if (fr < 8) { st_bf4(dst + rowB * 32 + 4 * fr, y0, y1, y2, y3); st_f4(o + (long)R * 32 + 4 * fr, y0, y1, y2, y3); }
        else if (fr < 10) st_f4(wdst + (long)R * 8 + 4 * (fr - 8), v0 * 0.0625f, v1 * 0.0625f, v2 * 0.0625f, v3 * 0.0625f);
      }
    } break;
  }
#undef ROWINFO
#undef ROPE64
#undef ROPE32
}

DI void tr8(unsigned addr, s16x4& l0, s16x4& l1, s16x4& l2, s16x4& l3, s16x4& h0, s16x4& h1, s16x4& h2, s16x4& h3) {
  asm volatile(
      "ds_read_b64_tr_b16 %0, %8\n\t"
      "ds_read_b64_tr_b16 %1, %8 offset:32\n\t"
      "ds_read_b64_tr_b16 %2, %8 offset:64\n\t"
      "ds_read_b64_tr_b16 %3, %8 offset:96\n\t"
      "ds_read_b64_tr_b16 %4, %8 offset:2560\n\t"
      "ds_read_b64_tr_b16 %5, %8 offset:2592\n\t"
      "ds_read_b64_tr_b16 %6, %8 offset:2624\n\t"
      "ds_read_b64_tr_b16 %7, %8 offset:2656\n\t"
      "s_waitcnt lgkmcnt(0)"
      : "=&v"(l0), "=&v"(l1), "=&v"(l2), "=&v"(l3), "=&v"(h0), "=&v"(h1), "=&v"(h2), "=&v"(h3)
      : "v"(addr)
      : "memory");
}

template <int MODE, bool F32KV = false>
DI void attn8(const bf16_t* __restrict__ Q, int ldq, int nq, const bf16_t* __restrict__ Kg, const bf16_t* __restrict__ Vg,
              int ldk, int nkeys, int tlo0, int thi0, int tlo1, int thi1, const bf16_t* __restrict__ gate, bf16_t* __restrict__ O,
              const float* __restrict__ biasg, int rel00, int rel01, const unsigned* __restrict__ maskg, int mask_ld, char* smem,
              const float* __restrict__ Kf = nullptr, const float* __restrict__ Vf = nullptr, int nf32t = 0) {
  bf16_t* sK = (bf16_t*)smem;
  bf16_t* sV = sK + 64 * LDT;
  float* sb = (float*)(sV + 64 * LDT);
  int tid = threadIdx.x;
  asm volatile("" : "+v"(tid));
  const int lane = tid & 63, wave = tid >> 6, c = lane & 15, g = lane >> 4;
  const int hf = wave >> 2, w4 = wave & 3;
  const int qin = w4 * 16 + c;
  const int qrow = hf * 64 + qin;
  const int qrc = qrow < nq ? qrow : nq - 1;
  const bool wactive = (hf * 64 + w4 * 16) < nq;
  const int tlo = hf ? tlo1 : tlo0, thi = hf ? thi1 : thi0, rel0 = hf ? rel01 : rel00;
  const int tbeg = tlo0 < tlo1 ? tlo0 : tlo1, tend = thi0 > thi1 ? thi0 : thi1;
  bf16x8 qB[2];
  qB[0] = *(const bf16x8*)(Q + (long)qrc * ldq + g * 8);
  qB[1] = *(const bf16x8*)(Q + (long)qrc * ldq + 32 + g * 8);
  __syncthreads();
  if (MODE == 1) {
    for (int i = tid; i < 513; i += 512) sb[i] = biasg[i] * LOG2E;
  }
  f32x4 o[4];
#pragma unroll
  for (int dt = 0; dt < 4; ++dt) o[dt] = (f32x4){0.f, 0.f, 0.f, 0.f};
  float m_run = -INFINITY, l_part = 0.f;
  const int skey = tid >> 3, sc16 = tid & 7;
  u32x4 aK0, aK1, aV0, aV1, bK0, bK1, bV0, bV1;
  aK1 = aV1 = bK1 = bV1 = (u32x4){0u, 0u, 0u, 0u};
  auto load_tile = [&](const int tile, u32x4& rk0, u32x4& rk1, u32x4& rv0, u32x4& rv1) __attribute__((always_inline)) {
    int key = tile * 64 + skey;
    key = key < nkeys ? key : nkeys - 1;
    if (F32KV && tile < nf32t) {
      const float* kp = Kf + (long)key * ldk + sc16 * 8;
      const float* vp = Vf + (long)key * ldk + sc16 * 8;
      rk0 = *(const u32x4*)kp; rk1 = *(const u32x4*)(kp + 4);
      rv0 = *(const u32x4*)vp; rv1 = *(const u32x4*)(vp + 4);
    } else {
      rk0 = *(const u32x4*)(Kg + (long)key * ldk + sc16 * 8);
      rv0 = *(const u32x4*)(Vg + (long)key * ldk + sc16 * 8);
    }
  };
  auto pack8 = [&](const u32x4& a, const u32x4& b) __attribute__((always_inline)) {
    u32x4 o;
    o.x = cvt_pk_bf16(__uint_as_float(a.x), __uint_as_float(a.y));
    o.y = cvt_pk_bf16(__uint_as_float(a.z), __uint_as_float(a.w));
    o.z = cvt_pk_bf16(__uint_as_float(b.x), __uint_as_float(b.y));
    o.w = cvt_pk_bf16(__uint_as_float(b.z), __uint_as_float(b.w));
    return o;
  };
  load_tile(tbeg, aK0, aK1, aV0, aV1);
  load_tile(tbeg + 1, bK0, bK1, bV0, bV1);
  const unsigned vaddr0 = (unsigned)(size_t)sV + (unsigned)((4 * g + (c >> 2)) * (LDT * 2) + (c & 3) * 8);
  u32x2 mwn = (u32x2){0u, 0u}, mwn2 = (u32x2){0u, 0u};
  if (MODE == 2) mwn2 = *(const u32x2*)(maskg + (long)qrc * mask_ld + tbeg * 2);
  auto step = [&](const int tile, u32x4& rk0, u32x4& rk1, u32x4& rv0, u32x4& rv1) __attribute__((always_inline)) {
    __syncthreads();
    if (F32KV && tile < nf32t) {
      *(u32x4*)(sK + skey * LDT + sc16 * 8) = pack8(rk0, rk1);
      *(u32x4*)(sV + skey * LDT + sc16 * 8) = pack8(rv0, rv1);
    } else {
      *(u32x4*)(sK + skey * LDT + sc16 * 8) = rk0;
      *(u32x4*)(sV + skey * LDT + sc16 * 8) = rv0;
    }
    __syncthreads();
    if (tile + 2 < tend) load_tile(tile + 2, rk0, rk1, rv0, rv1);
    if (MODE == 2) { mwn = mwn2; if (tile + 1 < tend) mwn2 = *(const u32x2*)(maskg + (long)qrc * mask_ld + (tile + 1) * 2); }
    if (wactive && tile >= tlo && tile < thi) {
      f32x4 s[4];
#pragma unroll
      for (int t = 0; t < 4; ++t) {
        s[t] = (f32x4){0.f, 0.f, 0.f, 0.f};
#pragma unroll
        for (int kb = 0; kb < 2; ++kb) {
          const bf16x8 kf = *(const bf16x8*)(sK + (16 * t + c) * LDT + kb * 32 + g * 8);
          s[t] = __builtin_amdgcn_mfma_f32_16x16x32_bf16(kf, qB[kb], s[t], 0, 0, 0);
        }
      }
      const int kbase = tile * 64 + 4 * g;
      if (MODE == 1) {
#pragma unroll
        for (int t = 0; t < 4; ++t)
#pragma unroll
          for (int i = 0; i < 4; ++i) {
            int d = rel0 + qin - (kbase + 16 * t + i);
            d = d < -256 ? -256 : (d > 256 ? 256 : d);
            s[t][i] += sb[d + 256];
          }
      }
      if (MODE == 2) {
        const u32x2 mw = mwn;
#pragma unroll
        for (int t = 0; t < 4; ++t) {
          const unsigned w = (t >> 1) ? mw.y : mw.x;
#pragma unroll
          for (int i = 0; i < 4; ++i) {
            const int bit = (t & 1) * 16 + 4 * g + i;
            if (!((w >> bit) & 1u)) s[t][i] = -INFINITY;
          }
        }
      }
      if (tile * 64 + 64 > nkeys) {
#pragma unroll
        for (int t = 0; t < 4; ++t)
#pragma unroll
          for (int i = 0; i < 4; ++i)
            if (kbase + 16 * t + i >= nkeys) s[t][i] = -INFINITY;
      }
      float mx = -INFINITY;
#pragma unroll
      for (int t = 0; t < 4; ++t)
#pragma unroll
        for (int i = 0; i < 4; ++i) mx = fmaxf(mx, s[t][i]);
      mx = fmaxf(mx, __shfl_xor(mx, 16));
      mx = fmaxf(mx, __shfl_xor(mx, 32));
      const float m_new = fmaxf(m_run, mx);
      const float m_safe = (m_new == -INFINITY) ? 0.f : m_new;
      const float alpha = __builtin_amdgcn_exp2f(m_run - m_safe);
      m_run = m_new;
      float psum = 0.f;
#pragma unroll
      for (int t = 0; t < 4; ++t)
#pragma unroll
        for (int i = 0; i < 4; ++i) {
          s[t][i] = __builtin_amdgcn_exp2f(s[t][i] - m_safe);
          psum += s[t][i];
        }
      l_part = l_part * alpha + psum;
#pragma unroll
      for (int dt = 0; dt < 4; ++dt)
#pragma unroll
        for (int i = 0; i < 4; ++i) o[dt][i] *= alpha;
#pragma unroll
      for (int kb2 = 0; kb2 < 2; ++kb2) {
        u32x4 pk;
        pk.x = cvt_pk_bf16(s[2 * kb2][0], s[2 * kb2][1]);
        pk.y = cvt_pk_bf16(s[2 * kb2][2], s[2 * kb2][3]);
        pk.z = cvt_pk_bf16(s[2 * kb2 + 1][0], s[2 * kb2 + 1][1]);
        pk.w = cvt_pk_bf16(s[2 * kb2 + 1][2], s[2 * kb2 + 1][3]);
        const bf16x8 pB = __builtin_bit_cast(bf16x8, pk);
        s16x4 lo[4], hi[4];
        tr8(vaddr0 + kb2 * 32 * (LDT * 2), lo[0], lo[1], lo[2], lo[3], hi[0], hi[1], hi[2], hi[3]);
#pragma unroll
        for (int dt = 0; dt < 4; ++dt) {
          const bf16x8 vf = __builtin_shufflevector(lo[dt], hi[dt], 0, 1, 2, 3, 4, 5, 6, 7);
          o[dt] = __builtin_amdgcn_mfma_f32_16x16x32_bf16(vf, pB, o[dt], 0, 0, 0);
        }
      }
    }
  };
  for (int tile = tbeg; tile < tend; tile += 2) {
    step(tile, aK0, aK1, aV0, aV1);
    if (tile + 1 < tend) step(tile + 1, bK0, bK1, bV0, bV1);
  }
  float l = l_part;
  l += __shfl_xor(l, 16);
  l += __shfl_xor(l, 32);
  const float inv = 1.0f / l;
  if (qrow < nq) {
#pragma unroll
    for (int dt = 0; dt < 4; ++dt) {
      const int d0 = 16 * dt + 4 * g;
      const u32x2 gg = *(const u32x2*)(gate + (long)qrow * 1024 + d0);
      u32x2 ov;
      ov.x = cvt_pk_bf16(o[dt][0] * inv * bf2f(gg.x & 0xffffu), o[dt][1] * inv * bf2f(gg.x >> 16));
      ov.y = cvt_pk_bf16(o[dt][2] * inv * bf2f(gg.y & 0xffffu), o[dt][3] * inv * bf2f(gg.y >> 16));
      *(u32x2*)(O + (long)qrow * 1024 + d0) = ov;
    }
  }
}

template <int NJ>
DI void select_query(const unsigned* sc, int N, unsigned* __restrict__ maskrow, int lane) {
  unsigned u[NJ];
#pragma unroll
  for (int j = 0; j < NJ; ++j) {
    const int idx = 64 * j + lane;
    u[j] = idx < N ? sc[idx] : 0u;
  }
  unsigned T = (N > 256) ? 0u : 1u;
  if (N > 256) {
    for (int bit = 31; bit >= 0; --bit) {
      const unsigned cand = T | (1u << bit);
      int cnt = 0;
#pragma unroll
      for (int j = 0; j < NJ; ++j) cnt += __popcll(__ballot(u[j] >= cand));
      if (cnt >= 256) { T = cand; if (cnt == 256) break; }
    }
  }
  int cgt = 0;
#pragma unroll
  for (int j = 0; j < NJ; ++j) cgt += __popcll(__ballot(u[j] > T));
  const int need = 256 - cgt;
  int running = 0;
#pragma unroll
  for (int j = 0; j < NJ; ++j) {
    const unsigned long long eq = __ballot(u[j] == T);
    const int rank = running + (int)__builtin_amdgcn_mbcnt_hi((unsigned)(eq >> 32), __builtin_amdgcn_mbcnt_lo((unsigned)eq, 0u));
    const bool sel = (u[j] > T) || (u[j] == T && rank < need);
    const unsigned long long sm = __ballot(sel);
    running += __popcll(eq);
    if (lane == 0) {
      u32x2 w;
      w.x = (unsigned)sm;
      w.y = (unsigned)(sm >> 32);
      *(u32x2*)(maskrow + 2 * j) = w;
    }
  }
}
DI void select_item8(const bf16_t* __restrict__ Qi, const float* __restrict__ Wi, long q0, const bf16_t* __restrict__ Ki, int N,
                     unsigned* __restrict__ maskbase, int mask_ld, char* smemA, char* smemB) {
  int tid = threadIdx.x;
  asm volatile("" : "+v"(tid));
  const int lane = tid & 63, wave = tid >> 6, r = lane & 31, hh = lane >> 5;
  const int hf = wave >> 2, w4 = wave & 3;
  unsigned* sc = (unsigned*)(hf ? smemB : smemA);
  const long qb = q0 + hf * 4;
  const int qsel = 2 * ((r >> 2) & 1) + (r >> 4), head = 4 * ((r >> 3) & 1) + (r & 3);
  bf16x8 a[2];
  a[0] = *(const bf16x8*)(Qi + (qb + qsel) * 256 + head * 32 + hh * 8);
  a[1] = *(const bf16x8*)(Qi + (qb + qsel) * 256 + head * 32 + 16 + hh * 8);
  float w[2][8];
#pragma unroll
  for (int qq = 0; qq < 2; ++qq) {
    const float4 w0 = *(const float4*)(Wi + (qb + 2 * hh + qq) * 8);
    const float4 w1 = *(const float4*)(Wi + (qb + 2 * hh + qq) * 8 + 4);
    w[qq][0] = w0.x; w[qq][1] = w0.y; w[qq][2] = w0.z; w[qq][3] = w0.w;
    w[qq][4] = w1.x; w[qq][5] = w1.y; w[qq][6] = w1.z; w[qq][7] = w1.w;
  }
  __syncthreads();
  const int ntile = (N + 31) >> 5;
  for (int nt = w4; nt < ntile; nt += 4) {
    const int key = nt * 32 + r;
    const int keyc = key < N ? key : N - 1;
    const bf16x8 b0 = *(const bf16x8*)(Ki + (long)keyc * 32 + hh * 8);
    const bf16x8 b1 = *(const bf16x8*)(Ki + (long)keyc * 32 + 16 + hh * 8);
    f32x16 acc;
#pragma unroll
    for (int i = 0; i < 16; ++i) acc[i] = 0.f;
    acc = __builtin_amdgcn_mfma_f32_32x32x16_bf16(a[0], b0, acc, 0, 0, 0);
    acc = __builtin_amdgcn_mfma_f32_32x32x16_bf16(a[1], b1, acc, 0, 0, 0);
#pragma unroll
    for (int qq = 0; qq < 2; ++qq) {
      float s = 0.f;
#pragma unroll
      for (int h = 0; h < 8; ++h) s += w[qq][h] * fmaxf(acc[8 * qq + h], 0.f);
      unsigned ub = __float_as_uint(s);
      ub = (ub & 0x80000000u) ? ~ub : (ub | 0x80000000u);
      if (key < N) sc[(2 * hh + qq) * SC_LD + key] = ub;
    }
  }
  __syncthreads();
  const unsigned* row = sc + w4 * SC_LD;
  unsigned* mrow = maskbase + (long)wave * mask_ld;
  if (N <= 512) select_query<8>(row, N, mrow, lane);
  else if (N <= 1024) select_query<16>(row, N, mrow, lane);
  else if (N <= 1536) select_query<24>(row, N, mrow, lane);
  else if (N <= 2048) select_query<32>(row, N, mrow, lane);
  else select_query<65>(row, N, mrow, lane);
}


#define XB_TMO      128
#define XB_XCNT(j)  (256  + 64 * (j))
#define XB_XSUB(j)  (1280 + 64 * (j))
#define XB_XGEN(j)  (2304 + 64 * (j))
#define XB_TOP      3328
#define XB_TOPGEN   3392
#define XCD_BAR_WORDS 3456
#define XB_SPIN_CAP (1u << 22)
DI unsigned xb_ld(unsigned* p) { return __hip_atomic_load(p, __ATOMIC_RELAXED, __HIP_MEMORY_SCOPE_AGENT); }
DI unsigned xb_add(unsigned* p, unsigned v) { return __hip_atomic_fetch_add(p, v, __ATOMIC_RELAXED, __HIP_MEMORY_SCOPE_AGENT); }
DI unsigned xb_xcc_id() { return (unsigned)__builtin_amdgcn_s_getreg((3 << 11) | 20) & 0xFu; }
#define XB_SPIN(cond, bar) do { unsigned _sp = 0; while (cond) { __builtin_amdgcn_s_sleep(1); \
    if ((++_sp & 255u) == 0u) { if (xb_ld(&(bar)[XB_TMO])) break; if (_sp > XB_SPIN_CAP) { atomicAdd(&(bar)[XB_TMO], 1u); break; } } } } while (0)
struct XcdBarrier { unsigned* bar; unsigned x; volatile LAS unsigned* st; };
DI XcdBarrier xcd_barrier_post(unsigned* bar, volatile LAS unsigned* st) {
  XcdBarrier b; b.bar = bar; b.x = xb_xcc_id(); b.st = st;
  if (threadIdx.x == 0) (void)xb_add(&bar[XB_XCNT(b.x)], 1u);
  return b;
}
DI void xcd_barrier_complete(unsigned* bar, unsigned x, unsigned& nloc, unsigned& nx) {
  const unsigned G = gridDim.x * gridDim.y * gridDim.z;
  unsigned sum, cnt, mine, sp = 0u;
  for (;;) {
    sum = 0u; cnt = 0u; mine = 0u;
#pragma unroll
    for (unsigned j = 0; j < 16; ++j) { const unsigned c = xb_ld(&bar[XB_XCNT(j)]); sum += c; cnt += (c > 0u) ? 1u : 0u; mine = (j == x) ? c : mine; }
    if (sum == G) break;
    __builtin_amdgcn_s_sleep(1);
    if ((++sp & 255u) == 0u) { if (xb_ld(&bar[XB_TMO])) break; if (sp > XB_SPIN_CAP) { atomicAdd(&bar[XB_TMO], 1u); break; } }
  }
  nloc = mine > 0u ? mine : 1u; nx = cnt > 0u ? cnt : 1u;
}
DI void xcd_barrier(const XcdBarrier& b) {
  asm volatile("s_waitcnt vmcnt(0)" ::: "memory");
  __syncthreads();
  if (threadIdx.x == 0) {
    unsigned* bar = b.bar;
    __builtin_amdgcn_s_waitcnt(0);
    unsigned nloc = b.st[0], nx = b.st[1];
    if (nloc == 0u) { xcd_barrier_complete(bar, b.x, nloc, nx); b.st[0] = nloc; b.st[1] = nx; }
    const unsigned old = xb_add(&bar[XB_XSUB(b.x)], 1u);
    const unsigned gen = old / nloc;
    if (old + 1u == (gen + 1u) * nloc) {
      __builtin_amdgcn_fence(__ATOMIC_RELEASE, "agent");
      asm volatile("s_waitcnt vmcnt(0)" ::: "memory");
      const unsigned og = xb_add(&bar[XB_TOP], 1u);
      const unsigned tg = og / nx;
      if (og + 1u == (tg + 1u) * nx) xb_add(&bar[XB_TOPGEN], 1u);
      else XB_SPIN(xb_ld(&bar[XB_TOPGEN]) == tg, bar);
      __builtin_amdgcn_fence(__ATOMIC_ACQUIRE, "agent");
      xb_add(&bar[XB_XGEN(b.x)], 1u);
      asm volatile("s_waitcnt vmcnt(0)" ::: "memory");
    } else {
      XB_SPIN(xb_ld(&bar[XB_XGEN(b.x)]) == gen, bar);
      __builtin_amdgcn_fence(__ATOMIC_ACQUIRE, "agent");
      asm volatile("s_waitcnt vmcnt(0)" ::: "memory");
    }
  }
  __syncthreads();
}

__global__ void __launch_bounds__(512, 2) fwd_megakernel(Params p) {
  cg::grid_group grid = cg::this_grid();
  __shared__ __attribute__((aligned(1024))) char smemA[SMEM_BYTES / 2];
  __shared__ __attribute__((aligned(1024))) char smemB[SMEM_BYTES / 2];
  char* const smem = smemA;
  __shared__ uint4 xb_words;
  __shared__ int s_next;
  const int tid = threadIdx.x, lane = tid & 63, wave = tid >> 6;
  const int nblk = gridDim.x, bid = blockIdx.x;
  if (tid == 0) xb_words = make_uint4(0u, 0u, 0u, 0u);
  __syncthreads();
  const XcdBarrier xb = xcd_barrier_post(p.bar, (volatile LAS unsigned*)&xb_words);
  if (p.use_cg) grid.sync();

  for (int rep0 = 0; rep0 < REP0; ++rep0) {
    const int half = tid >> 8, t = tid & 255;
    float* smf = (float*)smem + half * (64 * 65);
    for (int base = bid * 2; base < 1024 + 128 + 256; base += nblk * 2) {
      const int it = base + half;
      const bool valid = it < 1408;
      if (it < 1024) p0_transpose_w(p.w_in, NCOL, 1024, p.WinT, it >> 6, it & 63, smf, valid, t);
      else if (it < 1152) { const int j = it - 1024; p0_transpose_w(p.w_mem, 512, 1024, p.WmemT, j >> 3, j & 7, smf, valid, t); }
      else { const int j = (valid ? it : 1407) - 1152; p0_transpose_w(p.w_out, 1024, 1024, p.WoutT, j >> 4, j & 15, smf, valid, t); }
    }
    {
      const int nrows = TP + TS + TM, stride = nblk * 8;
      auto rowptr = [&](int row) {
        RowPtr r;
        if (row < TP) { r.src = p.x_p + (long)row * 1024; r.g = p.g_mix; r.dst = p.xn_p + (long)row * 1024; }
        else if (row < TP + TS) { const int r2 = row - TP; r.src = p.x_s + (long)r2 * 1024; r.g = p.g_mix; r.dst = p.xn_s + (long)r2 * 1024; }
        else { const int r2 = row - TP - TS; r.src = p.mem_p + (long)r2 * 1024; r.g = p.g_mem; r.dst = p.memn + (long)r2 * 1024; }
        return r;
      };
      int row = bid * 8 + wave;
      for (; row + 3 * stride < nrows; row += 4 * stride) {
        const RowPtr rp[4] = {rowptr(row), rowptr(row + stride), rowptr(row + 2 * stride), rowptr(row + 3 * stride)};
        p0_rownorm<4>(rp, lane);
      }
      for (; row < nrows; row += stride) {
        const RowPtr rp[1] = {rowptr(row)};
        p0_rownorm<1>(rp, lane);
      }
    }
    const long gtid = (long)bid * 512 + tid, gn = (long)nblk * 512;
    p0_convert(p.cak, p.Ka_s, 8, 512L * 384, 544L * 384, gtid, gn);
    p0_convert(p.cav, p.Va_s, 8, 512L * 384, 544L * 384, gtid, gn);
    p0_convert(p.cbi, p.Ki_s, 8, 4096L * 32, 4128L * 32, gtid, gn);
    p0_convert(p.cmk, p.Mk_s, 1, 8L * 256 * 256, 0, gtid, gn);
    p0_convert(p.cmv, p.Mv_s, 1, 8L * 256 * 256, 0, gtid, gn);
    for (long i = gtid; i < 2080 * 32; i += gn) {
      const int pr = (int)(i >> 5), k = (int)(i & 31);
      const int pos = pr < 2048 ? pr : (4096 + pr - 2048);
      const float invf = (float)exp2((double)k * -0.41524101186092029);
      const float ang = (float)pos * invf;
      double rev = (double)ang * 0.15915494309189533577;
      rev = rev - rint(rev);
      const float fr = (float)rev;
      p.rope[i] = make_float2(__builtin_amdgcn_cosf(fr), __builtin_amdgcn_sinf(fr));
    }
  }
  xcd_barrier(xb);

  {
    for (int round9 = 0; round9 < 9 * REP1; ++round9)
      for (int vb = bid; vb < 256; vb += nblk) {
        const int round = round9 % 9;
        int kind, gm, gn;
        if (round < 8) {
          const int xcd = vb & 7, slot = vb >> 3;
          kind = 0; gm = (round * 4 + (xcd >> 1)) * 4 + (slot & 3); gn = ((xcd + round) & 1) * 8 + (((slot >> 2) + round) & 7);
        } else if (vb < 16) { kind = 1; gm = 0; gn = vb; }
        else if (vb < 48) { kind = 2; gm = (vb - 16) >> 1; gn = (vb - 16) & 1; }
        else continue;
        const bf16_t* Ap = kind == 0 ? p.xn_p : (kind == 1 ? p.xn_s : p.memn);
        const bf16_t* Bp = kind == 2 ? p.WmemT : p.WinT;
        f32x4 acc[8][4];
        gemm256(Ap, Bp, 1024, gm * 256, gn * 256, smemA, smemB, acc);
        int tq = threadIdx.x;
        asm volatile("" : "+v"(tq));
        const int lane = tq & 63, wr = tq >> 8, wc = (tq >> 6) & 3;
        const int R0 = gm * 256 + wr * 128, cgc = gn * 256 + wc * 64;
        if (kind == 0) epi_mix8<false>(p, acc, R0, cgc, lane);
        else if (kind == 1) epi_mix8<true>(p, acc, R0, cgc, lane);
        else {
          const bool isv = cgc >= 256;
          bf16_t* dst = isv ? p.Mv_p : p.Mk_p;
          float* o = p.out + (isv ? O_MVP : O_MKP);
          const int cc = (cgc & 255) + 4 * (lane & 15);
          ROWLOOP8 {
            SCHED();
            const int R = R0 + m * 16 + (lane >> 4) * 4 + j;
            st_bf4(dst + (long)R * 256 + cc, acc[m][0][j], acc[m][1][j], acc[m][2][j], acc[m][3][j]);
            st_f4(o + (long)R * 256 + cc, acc[m][0][j], acc[m][1][j], acc[m][2][j], acc[m][3][j]);
          }
        }
      }
  }
  xcd_barrier(xb);

#define QUEUE_BEGIN(ctrp, total)                                              \
  { unsigned* _ctr = (ctrp); const int _total = (total);                     \
    __syncthreads();                                                          \
    if (tid == 0) s_next = (int)atomicAdd(_ctr, 1u);                          \
    __syncthreads();                                                          \
    int it = s_next;                                                          \
    while (it < _total) {                                                     \
      int _nxt = 0;                                                           \
      if (tid == 0) _nxt = (int)atomicAdd(_ctr, 1u);
#define QUEUE_END                                                             \
      __syncthreads();                                                        \
      if (tid == 0) s_next = _nxt;                                            \
      __syncthreads();                                                        \
      it = s_next;                                                            \
    } }

  {
    const int e0 = 32, e1 = e0 + 48, e2 = e1 + 32, e3 = e2 + 4096, e4 = e3 + 1536, e5 = e4 + 1024;
    QUEUE_BEGIN(p.ctr, REP2 * e5)
      const int iq = it % e5;
      if (iq < e0) {
        const int b = iq >> 2, qg = iq & 3;
        const long q0 = (long)b * 32 + qg * 8;
        select_item8(p.Qi_s, p.Wi_s, q0, p.Ki_s + (long)b * 4128 * 32, 4128, p.Mask_s + q0 * MASK_LD_S, MASK_LD_S, smemA, smemB);
      } else if (iq < e1) {
        const int j = iq - e0, b = j / 6, h = j % 6;
        attn8<1>(p.Qa_s + (long)b * 32 * 384 + h * 64, 384, 32, p.Ka_s + (long)b * 544 * 384 + h * 64, p.Va_s + (long)b * 544 * 384 + h * 64,
                 384, 544, 0, 9, 0, 0, p.Gate_s + (long)b * 32 * 1024 + h * 64, p.O_s + (long)b * 32 * 1024 + h * 64, p.relb + h * 513, 512, 0,
                 nullptr, 0, smem);
      } else if (iq < e2) {
        const int j = iq - e1, b = j >> 2, h = j & 3;
        attn8<0>(p.Qm_s + (long)b * 32 * 256 + h * 64, 256, 32, p.Mk_s + (long)b * 65536 + h * 64, p.Mv_s + (long)b * 65536 + h * 64, 256, 256,
                 0, 4, 0, 0, p.Gate_s + (long)b * 32 * 1024 + 768 + h * 64, p.O_s + (long)b * 32 * 1024 + 768 + h * 64, nullptr, 0, 0, nullptr, 0,
                 smem);
      } else if (iq < e3) {
        const int j = iq - e2, c = 31 - (j >> 7), rem = j & 127, b = rem >> 3, qg = rem & 7;
        const long q0 = (long)b * 2048 + c * 64 + qg * 8;
        select_item8(p.Qi_p, p.Wi_p, q0, p.Ki_p + (long)b * 2048 * 32, (c + 1) * 64, p.Mask_p + q0 * MASK_LD_P, MASK_LD_P, smemA, smemB);
      } else if (iq < e4) {
        const int j = iq - e3, b = j / 96, cp = (j / 6) & 15, h = j % 6;
        const int c0 = 2 * cp, c1 = c0 + 1, kb0 = c0 > 8 ? c0 - 8 : 0, k0 = kb0 * 64;
        const long row0 = (long)b * 2048 + c0 * 64, krow = (long)b * 2048 + k0;
        attn8<1>(p.Qa_p + row0 * 384 + h * 64, 384, 128, p.Ka_p + krow * 384 + h * 64, p.Va_p + krow * 384 + h * 64, 384, (c1 + 1) * 64 - k0,
                 0, c0 - kb0 + 1, (c1 > 8 ? c1 - 8 : 0) - kb0, c1 - kb0 + 1, p.Gate_p + row0 * 1024 + h * 64, p.O_p + row0 * 1024 + h * 64,
                 p.relb + h * 513, c0 * 64 - k0, c1 * 64 - k0, nullptr, 0, smem);
      } else {
        const int j = iq - e4, b = j >> 6, cp = (j >> 2) & 15, h = j & 3;
        const long row0 = (long)b * 2048 + cp * 128;
        attn8<0>(p.Qm_p + row0 * 256 + h * 64, 256, 128, p.Mk_p + (long)b * 65536 + h * 64, p.Mv_p + (long)b * 65536 + h * 64, 256, 256, 0, 4, 0, 4,
                 p.Gate_p + row0 * 1024 + 768 + h * 64, p.O_p + row0 * 1024 + 768 + h * 64, nullptr, 0, 0, nullptr, 0, smem);
      }
    QUEUE_END
  }
  xcd_barrier(xb);

  {
    const int nB_s = 48, nB_p = 1536;
    QUEUE_BEGIN(p.ctr + 64, REP3 * (nB_s + nB_p))
      const int iq = it % (nB_s + nB_p);
      if (iq < nB_s) {
        const int b = iq / 6, h = iq % 6;
        attn8<2, true>(p.Qb_s + (long)b * 32 * 384 + h * 64, 384, 32, p.Kb_s + (long)b * 4128 * 384 + h * 64, p.Vb_s + (long)b * 4128 * 384 + h * 64,
                 384, 4128, 0, 65, 0, 0, p.Gate_s + (long)b * 32 * 1024 + 384 + h * 64, p.O_s + (long)b * 32 * 1024 + 384 + h * 64, nullptr, 0, 0,
                 p.Mask_s + (long)b * 32 * MASK_LD_S, MASK_LD_S, smem, p.cbk + (long)b * 4096 * 384 + h * 64, p.cbv + (long)b * 4096 * 384 + h * 64, 64);
      } else {
        const int j = iq - nB_s, cp = 15 - j / 96, rem = j % 96, b = rem / 6, h = rem % 6;
        const int c0 = 2 * cp, c1 = c0 + 1;
        const long row0 = (long)b * 2048 + c0 * 64;
        attn8<2>(p.Qb_p + row0 * 384 + h * 64, 384, 128, p.Kb_p + (long)b * 2048 * 384 + h * 64, p.Vb_p + (long)b * 2048 * 384 + h * 64, 384,
                 (c1 + 1) * 64, 0, c0 + 1, 0, c1 + 1, p.Gate_p + row0 * 1024 + 384 + h * 64, p.O_p + row0 * 1024 + 384 + h * 64, nullptr, 0, 0,
                 p.Mask_p + row0 * MASK_LD_P, MASK_LD_P, smem);
      }
    QUEUE_END
  }
  xcd_barrier(xb);

  {
    const int wr = wave >> 2, wc = wave & 3, fr = lane & 15, fq = lane >> 4;
    float* red = (float*)smem;
    float* red2 = (float*)smem;
    float* rsv = (float*)smemB;
    for (int round = 0; round < 2; ++round)
      for (int vb = bid; vb < 256; vb += nblk) {
        const int gm = round * 64 + (vb & 7) * 8 + ((vb >> 3) & 7), gn = vb >> 6;
        f32x4 acc[8][4];
        gemm256(p.O_p, p.WoutT, 1024, gm * 256, gn * 256, smemA, smemB, acc);
        int tq = threadIdx.x;
        asm volatile("" : "+v"(tq));
        const int ln = tq & 63, wv = tq >> 6, wr = wv >> 2, wc = wv & 3;
        const int fr2 = ln & 15, fq2 = ln >> 4;
        const int R0 = gm * 256 + wr * 128, C0 = gn * 256 + wc * 64 + 4 * fr2;
        float4 xq[2][4];
#pragma unroll
        for (int jj = 0; jj < 4; ++jj) { const f32x4 t4 = __builtin_nontemporal_load((const f32x4*)(p.x_p + (long)(gm * 256 + wr * 128 + fq2 * 4 + jj) * 1024 + C0)); xq[0][jj] = make_float4(t4.x, t4.y, t4.z, t4.w); }
        ROWLOOP8 {
          SCHED();
          const int rl = wr * 128 + m * 16 + fq2 * 4 + j;
          if (j == 0 && m < 7) {
#pragma unroll
            for (int jj = 0; jj < 4; ++jj) { const f32x4 t4 = __builtin_nontemporal_load((const f32x4*)(p.x_p + (long)(gm * 256 + wr * 128 + (m + 1) * 16 + fq2 * 4 + jj) * 1024 + C0)); xq[(m + 1) & 1][jj] = make_float4(t4.x, t4.y, t4.z, t4.w); }
          }
          const float4 xv = xq[m & 1][j];
          const float v0 = acc[m][0][j] + xv.x, v1 = acc[m][1][j] + xv.y, v2 = acc[m][2][j] + xv.z, v3 = acc[m][3][j] + xv.w;
          acc[m][0][j] = v0; acc[m][1][j] = v1; acc[m][2][j] = v2; acc[m][3][j] = v3;
          red2[rl * 65 + wc * 16 + fr2] = v0 * v0 + v1 * v1 + v2 * v2 + v3 * v3;
        }
        __syncthreads();
        if (tq < 256) {
          float mine = 0.f;
#pragma unroll 16
          for (int q = 0; q < 64; ++q) mine += red2[tq * 65 + q];
          __hip_atomic_store(p.xch + (long)(gm * 4 + gn) * 256 + tq, mine, __ATOMIC_RELAXED, __HIP_MEMORY_SCOPE_AGENT);
        }
        asm volatile("s_waitcnt vmcnt(0)" ::: "memory");
        __syncthreads();
        if (tq == 0) {
          (void)__hip_atomic_fetch_add(p.xcnt + gm, 1u, __ATOMIC_RELAXED, __HIP_MEMORY_SCOPE_AGENT);
          unsigned sp = 0;
          while (__hip_atomic_load(p.xcnt + gm, __ATOMIC_RELAXED, __HIP_MEMORY_SCOPE_AGENT) < 4u) {
            __builtin_amdgcn_s_sleep(1);
            if (++sp > (1u << 22)) break;
          }
        }
        __syncthreads();
        if (tq < 256) {
          float t = 0.f;
#pragma unroll
          for (int g4 = 0; g4 < 4; ++g4) t += __hip_atomic_load(p.xch + (long)(gm * 4 + g4) * 256 + tq, __ATOMIC_RELAXED, __HIP_MEMORY_SCOPE_AGENT);
          rsv[tq] = rsqrtf(t * (1.0f / 1024.0f) + 1e-6f);
        }
        __syncthreads();
        const float4 gf = *(const float4*)(p.g_fin + C0);
        int fq3 = fq2;
        asm volatile("" : "+v"(fq3));
        ROWLOOP8 {
          SCHED();
          const int rl = wr * 128 + m * 16 + fq3 * 4 + j;
          const float rs = rsv[rl];
          st_f4(p.out + O_YP + (long)(gm * 256 + rl) * 1024 + C0, acc[m][0][j] * rs * gf.x, acc[m][1][j] * rs * gf.y, acc[m][2][j] * rs * gf.z,
                acc[m][3][j] * rs * gf.w);
        }
      }
    __syncthreads();
    if (bid < 16) {
      int tss = threadIdx.x;
      asm volatile("" : "+v"(tss));
      const int tid = tss, lane = tss & 63, wave = tss >> 6, fr = lane & 15, fq = lane >> 4;
      (void)lane;
      const int r0 = bid * 16;
      f32x4 a8[8];
#pragma unroll
      for (int i = 0; i < 8; ++i) a8[i] = (f32x4){0.f, 0.f, 0.f, 0.f};
      const bf16_t* ap = p.O_s + (long)(r0 + fr) * 1024 + fq * 8;
#pragma unroll 2
      for (int ks = 0; ks < 32; ++ks) {
        const bf16x8 af = *(const bf16x8*)(ap + ks * 32);
#pragma unroll
        for (int i = 0; i < 8; ++i) {
          const int nb = 8 * wave + i;
          const bf16x8 bf = *(const bf16x8*)(p.WoutT + (long)((nb >> 2) * 64 + (nb & 3) * 16 + fr) * 1024 + fq * 8 + ks * 32);
          a8[i] = __builtin_amdgcn_mfma_f32_16x16x32_bf16(af, bf, a8[i], 0, 0, 0);
        }
      }
      float ssq[4] = {0.f, 0.f, 0.f, 0.f};
#pragma unroll
      for (int i = 0; i < 8; ++i) {
        const int nb = 8 * wave + i, col = (nb >> 2) * 64 + 4 * fr + (nb & 3);
#pragma unroll
        for (int j = 0; j < 4; ++j) {
          const float v = a8[i][j] + p.x_s[(long)(r0 + fq * 4 + j) * 1024 + col];
          a8[i][j] = v;
          ssq[j] += v * v;
        }
      }
#pragma unroll
      for (int j = 0; j < 4; ++j) {
#pragma unroll
        for (int o = 8; o >= 1; o >>= 1) ssq[j] += __shfl_xor(ssq[j], o);
      }
      __syncthreads();
      if (fr == 0) {
#pragma unroll
        for (int j = 0; j < 4; ++j) red[wave * 16 + fq * 4 + j] = ssq[j];
      }
      __syncthreads();
      if (tid < 16) {
        float t = 0.f;
#pragma unroll
        for (int w8 = 0; w8 < 8; ++w8) t += red[w8 * 16 + tid];
        rsv[tid] = rsqrtf(t * (1.0f / 1024.0f) + 1e-6f);
      }
      __syncthreads();
#pragma unroll
      for (int i = 0; i < 8; ++i) {
        const int nb = 8 * wave + i, col = (nb >> 2) * 64 + 4 * fr + (nb & 3);
        const float gcol = p.g_fin[col];
#pragma unroll
        for (int j = 0; j < 4; ++j) p.out[O_YS + (long)(r0 + fq * 4 + j) * 1024 + col] = a8[i][j] * rsv[fq * 4 + j] * gcol;
      }
    }
  }
}

extern "C" void kernel_launch(void* const* d_in, const int* in_sizes, int n_in, void* d_out, int out_size, void* d_ws, size_t ws_size,
                              hipStream_t stream) {
  static int grid_blocks = 0;
  if (!grid_blocks) {
    int dev = 0, cus = 0, per_cu = 0;
    (void)hipGetDevice(&dev);
    (void)hipDeviceGetAttribute(&cus, hipDeviceAttributeMultiprocessorCount, dev);
    (void)hipOccupancyMaxActiveBlocksPerMultiprocessor(&per_cu, fwd_megakernel, 512, 0);
    if (per_cu < 1) { fprintf(stderr, "occupancy query reports %d blocks/CU\n", per_cu); per_cu = 1; }
    grid_blocks = cus;
  }
  Params p{};
  p.x_p = (const float*)d_in[0]; p.x_s = (const float*)d_in[1]; p.mem_p = (const float*)d_in[2];
  p.cak = (const float*)d_in[3]; p.cav = (const float*)d_in[4]; p.cbk = (const float*)d_in[5]; p.cbv = (const float*)d_in[6];
  p.cbi = (const float*)d_in[7]; p.cmk = (const float*)d_in[8]; p.cmv = (const float*)d_in[9];
  p.g_mix = (const float*)d_in[10]; p.w_in = (const float*)d_in[11]; p.relb = (const float*)d_in[12];
  p.g_mem = (const float*)d_in[13]; p.w_mem = (const float*)d_in[14]; p.w_out = (const float*)d_in[15]; p.g_fin = (const float*)d_in[16];
  p.out = (float*)d_out;
  char* w = (char*)d_ws;
  size_t off = 0;
  auto take = [&](size_t bytes) { char* r = w + off; off += (bytes + 255) & ~(size_t)255; return r; };
  p.bar = (unsigned*)take((size_t)XCD_BAR_WORDS * 4 + 2048);
  p.ctr = p.bar + XCD_BAR_WORDS + 64;
  p.xcnt = p.bar + XCD_BAR_WORDS + 256;
  p.WinT = (bf16_t*)take((size_t)NPAD * 1024 * 2);
  p.WmemT = (bf16_t*)take((size_t)512 * 1024 * 2);
  p.WoutT = (bf16_t*)take((size_t)1024 * 1024 * 2);
  p.xn_p = (bf16_t*)take((size_t)TP * 1024 * 2);
  p.xn_s = (bf16_t*)take((size_t)TS * 1024 * 2);
  p.memn = (bf16_t*)take((size_t)TM * 1024 * 2);
  p.rope = (float2*)take((size_t)2080 * 32 * 8);
  p.Qa_p = (bf16_t*)take((size_t)TP * 384 * 2);
  p.Ka_p = (bf16_t*)take((size_t)TP * 384 * 2);
  p.Va_p = (bf16_t*)take((size_t)TP * 384 * 2);
  p.Qb_p = (bf16_t*)take((size_t)TP * 384 * 2);
  p.Kb_p = (bf16_t*)take((size_t)TP * 384 * 2);
  p.Vb_p = (bf16_t*)take((size_t)TP * 384 * 2);
  p.Gate_p = (bf16_t*)take((size_t)TP * 1024 * 2);
  p.Qm_p = (bf16_t*)take((size_t)TP * 256 * 2);
  p.Qi_p = (bf16_t*)take((size_t)TP * 256 * 2);
  p.Ki_p = (bf16_t*)take((size_t)TP * 32 * 2);
  p.Wi_p = (float*)take((size_t)TP * 8 * 4);
  p.Mk_p = (bf16_t*)take((size_t)TM * 256 * 2);
  p.Mv_p = (bf16_t*)take((size_t)TM * 256 * 2);
  p.Qa_s = (bf16_t*)take((size_t)TS * 384 * 2);
  p.Ka_s = (bf16_t*)take((size_t)8 * 544 * 384 * 2);
  p.Va_s = (bf16_t*)take((size_t)8 * 544 * 384 * 2);
  p.Qb_s = (bf16_t*)take((size_t)TS * 384 * 2);
  p.Kb_s = (bf16_t*)take((size_t)8 * 4128 * 384 * 2);
  p.Vb_s = (bf16_t*)take((size_t)8 * 4128 * 384 * 2);
  p.Gate_s = (bf16_t*)take((size_t)TS * 1024 * 2);
  p.Qm_s = (bf16_t*)take((size_t)TS * 256 * 2);
  p.Qi_s = (bf16_t*)take((size_t)TS * 256 * 2);
  p.Ki_s = (bf16_t*)take((size_t)8 * 4128 * 32 * 2);
  p.Wi_s = (float*)take((size_t)TS * 8 * 4);
  p.Mk_s = (bf16_t*)take((size_t)8 * 256 * 256 * 2);
  p.Mv_s = (bf16_t*)take((size_t)8 * 256 * 256 * 2);
  p.Mask_p = (unsigned*)take((size_t)TP * MASK_LD_P * 4);
  p.Mask_s = (unsigned*)take((size_t)TS * MASK_LD_S * 4);
  p.O_p = (bf16_t*)take((size_t)TP * 1024 * 2);
  p.O_s = (bf16_t*)take((size_t)TS * 1024 * 2);
  p.xch = (float*)take((size_t)128 * 4 * 256 * 4);
  p.use_cg = 0;
  if (off > ws_size) { fprintf(stderr, "workspace too small: need %zu have %zu\n", off, ws_size); return; }
  (void)hipMemsetAsync(p.bar, 0, (size_t)XCD_BAR_WORDS * 4 + 2048, stream);
  void* args[] = {&p};
  hipError_t e = hipLaunchCooperativeKernel((void*)fwd_megakernel, dim3(grid_blocks), dim3(512), args, 0, stream);
  if (e != hipSuccess) fprintf(stderr, "cooperative launch failed: %s (grid %d)\n", hipGetErrorString(e), grid_blocks);
}
```
